# Optimizing an MI355X kernel written in HIP

```python
import math
import jax, jax.numpy as jnp
from jax import lax
import numpy as np

D_MODEL = 1024
BATCH = 32
SEQ = 256
DEPTH = 2
DEC_BATCH = 4
DEC_SEQ = 1024
PAST_LEN = 512

GRID_W = 64
Q_BLOCK = 128
HEAD_DIM = 64
N_HEADS_A = D_MODEL // 2 // HEAD_DIM
N_KV_A = N_HEADS_A // 4
N_HEADS_B = D_MODEL // 4 // HEAD_DIM
DIFF_DIM = HEAD_DIM // 2
GROUP_C = 64
N_GROUPS_C = D_MODEL // 4 // GROUP_C
WIDTH_A = N_HEADS_A * HEAD_DIM
WIDTH_B = N_HEADS_B * HEAD_DIM
WIDTH_C = N_GROUPS_C * GROUP_C
MIX_WIDTH = WIDTH_A + WIDTH_B + WIDTH_C
KV_WIDTH_A = N_KV_A * HEAD_DIM
PROJ_SPLITS = (WIDTH_A, KV_WIDTH_A, KV_WIDTH_A, WIDTH_A,
               WIDTH_B, WIDTH_B, WIDTH_B, WIDTH_B,
               WIDTH_C, WIDTH_C)
D_IN = sum(PROJ_SPLITS)
RMS_EPS = 1e-6
ROPE_BASE = 10000.0

kernel_name = 'hybrid_diffusion_parallel_heads_step'


def rms_norm(x, g):
    xf = x.astype(jnp.float32)
    y = xf * lax.rsqrt(jnp.mean(xf * xf, axis=-1, keepdims=True) + RMS_EPS)
    return (y * g.astype(jnp.float32)).astype(x.dtype)


def split_columns(p):
    idx, acc = [], 0
    for w in PROJ_SPLITS[:-1]:
        acc += w
        idx.append(acc)
    return jnp.split(p, idx, axis=-1)


def axial_angles(n_tok, dim):
    rows = n_tok // GRID_W
    row = jnp.repeat(jnp.arange(rows), GRID_W).astype(jnp.float32)
    col = jnp.tile(jnp.arange(GRID_W), rows).astype(jnp.float32)
    n_freq = dim // 4
    inv = 1.0 / (ROPE_BASE ** (jnp.arange(n_freq, dtype=jnp.float32) / n_freq))
    return row[:, None] * inv, col[:, None] * inv


def rope_half(x, ang):
    shp = (ang.shape[0],) + (1,) * (x.ndim - 3) + (ang.shape[1],)
    cos = jnp.cos(ang).reshape(shp).astype(x.dtype)
    sin = jnp.sin(ang).reshape(shp).astype(x.dtype)
    x1, x2 = jnp.split(x, 2, axis=-1)
    return jnp.concatenate([x1 * cos - x2 * sin, x1 * sin + x2 * cos], axis=-1)


def rope_2d(x, angs):
    xr, xc = jnp.split(x, 2, axis=-1)
    return jnp.concatenate([rope_half(xr, angs[0]), rope_half(xc, angs[1])], axis=-1)


def sweep_query_blocks(fn, *qs):
    b, s = qs[0].shape[:2]
    nb = s // Q_BLOCK
    blocks = tuple(jnp.moveaxis(q.reshape((b, nb, Q_BLOCK) + q.shape[2:]), 1, 0) for q in qs)
    out = lax.map(lambda qb: fn(*qb), blocks)
    return jnp.moveaxis(out, 0, 1).reshape((b, s) + out.shape[3:])


def gqa_attention(q, k, v):
    b, _, h, d = q.shape
    kvh = k.shape[2]
    g = h // kvh
    scale = d ** -0.5

    def block(qb):
        qb = qb.reshape(b, Q_BLOCK, kvh, g, d)
        sc = jnp.einsum('bqhgd,bkhd->bhgqk', qb, k).astype(jnp.float32) * scale
        pr = jax.nn.softmax(sc, axis=-1).astype(v.dtype)
        o = jnp.einsum('bhgqk,bkhd->bqhgd', pr, v)
        return o.reshape(b, Q_BLOCK, h, d)

    return sweep_query_blocks(block, q)


def diff_attention(q1, q2, k1, k2, v, lam):
    scale = q1.shape[-1] ** -0.5

    def block(q1b, q2b):
        s1 = jnp.einsum('bqhd,bkhd->bhqk', q1b, k1).astype(jnp.float32) * scale
        s2 = jnp.einsum('bqhd,bkhd->bhqk', q2b, k2).astype(jnp.float32) * scale
        pr = jax.nn.softmax(s1, axis=-1) - lam * jax.nn.softmax(s2, axis=-1)
        return jnp.einsum('bhqk,bkhd->bqhd', pr.astype(v.dtype), v)

    return sweep_query_blocks(block, q1, q2)


def fourier_mix(u, w_c):
    b, s, _ = u.shape
    uf = u.astype(jnp.float32).reshape(b, s, N_GROUPS_C, GROUP_C)
    f = jnp.fft.fft2(uf, axes=(1, 3), norm='ortho').real
    return f.reshape(b, s, WIDTH_C).astype(u.dtype) @ w_c


def modulation(cond, w_mod, b_mod):
    m = jax.nn.silu(cond) @ w_mod + b_mod
    return jnp.split(m, 3, axis=-1)


def mixer_layer(x, shift, scale, gate, norm_g, w_in, qn_a, kn_a, qn_b, kn_b,
                lq1, lk1, lq2, lk2, subln_g, w_c, w_out, layer_idx,
                angs_a, angs_b, ctx_a, ctx_b):
    b, s, _ = x.shape
    h = rms_norm(x, norm_g) * (1.0 + scale) + shift
    qa, ka, va, ga, qb, kb, vb, gb, uc, gc = split_columns(h @ w_in)

    qa = rms_norm(qa.reshape(b, s, N_HEADS_A, HEAD_DIM), qn_a)
    ka = rms_norm(ka.reshape(b, s, N_KV_A, HEAD_DIM), kn_a)
    va = va.reshape(b, s, N_KV_A, HEAD_DIM)
    qb = rms_norm(qb.reshape(b, s, N_HEADS_B, 2, DIFF_DIM), qn_b)
    kb = rms_norm(kb.reshape(b, s, N_HEADS_B, 2, DIFF_DIM), kn_b)
    vb = vb.reshape(b, s, N_HEADS_B, HEAD_DIM)

    if ctx_a is None:
        new_a = jnp.stack([ka, va], axis=2)
        new_b = jnp.stack([kb.reshape(b, s, N_HEADS_B, HEAD_DIM), vb], axis=2)
        ka_all, va_all, kb_all, vb_all = ka, va, kb, vb
    else:
        new_a, new_b = None, None
        qa, ka = rope_2d(qa, angs_a), rope_2d(ka, angs_a)
        qb, kb = rope_2d(qb, angs_b), rope_2d(kb, angs_b)
        n_ctx = ctx_a.shape[1]
        ka_all = jnp.concatenate([ka, ctx_a[:, :, 0]], axis=1)
        va_all = jnp.concatenate([va, ctx_a[:, :, 1]], axis=1)
        kb_ctx = ctx_b[:, :, 0].reshape(b, n_ctx, N_HEADS_B, 2, DIFF_DIM)
        kb_all = jnp.concatenate([kb, kb_ctx], axis=1)
        vb_all = jnp.concatenate([vb, ctx_b[:, :, 1]], axis=1)

    oa = gqa_attention(qa, ka_all, va_all).reshape(b, s, WIDTH_A)

    lam_init = 0.8 - 0.6 * math.exp(-0.3 * layer_idx)
    lam = (jnp.exp(jnp.sum(lq1.astype(jnp.float32) * lk1.astype(jnp.float32)))
           - jnp.exp(jnp.sum(lq2.astype(jnp.float32) * lk2.astype(jnp.float32))) + lam_init)
    ob = diff_attention(qb[..., 0, :], qb[..., 1, :], kb_all[..., 0, :], kb_all[..., 1, :], vb_all, lam)
    ob = (rms_norm(ob, subln_g) * (1.0 - lam_init)).reshape(b, s, WIDTH_B)

    oc = fourier_mix(uc, w_c)

    mix = jnp.concatenate([oa * jax.nn.silu(ga), ob * jax.nn.silu(gb), oc * jax.nn.silu(gc)], axis=-1)
    return x + gate * (mix @ w_out), new_a, new_b


def setup_inputs(seed: int = 0) -> dict:
    key = jax.random.key(seed)
    ks = jax.random.split(key, 24)
    f32 = jnp.float32
    nrm = lambda k, shp: jax.random.normal(k, shp, f32)
    return {
        'x_prompt': nrm(ks[0], (BATCH, SEQ, D_MODEL)),
        'x_sample': nrm(ks[1], (DEC_BATCH, DEC_SEQ, D_MODEL)),
        'cache_attn_a': nrm(ks[2], (DEC_BATCH, DEPTH, PAST_LEN, 2, N_KV_A, HEAD_DIM)),
        'cache_attn_b': nrm(ks[3], (DEC_BATCH, DEPTH, PAST_LEN, 2, N_HEADS_B, HEAD_DIM)),
        'c': nrm(ks[4], (DEC_BATCH, D_MODEL)),
        'c_ctx': nrm(ks[5], (D_MODEL,)),
        'norm_g': 1.0 + 0.01 * nrm(ks[6], (DEPTH, D_MODEL)),
        'w_mod': nrm(ks[7], (DEPTH, D_MODEL, 3 * D_MODEL)) * (0.5 * D_MODEL ** -0.5),
        'b_mod': 0.01 * nrm(ks[8], (DEPTH, 3 * D_MODEL)),
        'w_in': nrm(ks[9], (DEPTH, D_MODEL, D_IN)) * D_MODEL ** -0.5,
        'q_norm_a': 1.0 + 0.01 * nrm(ks[10], (DEPTH, HEAD_DIM)),
        'k_norm_a': 1.0 + 0.01 * nrm(ks[11], (DEPTH, HEAD_DIM)),
        'q_norm_b': 1.0 + 0.01 * nrm(ks[12], (DEPTH, DIFF_DIM)),
        'k_norm_b': 1.0 + 0.01 * nrm(ks[13], (DEPTH, DIFF_DIM)),
        'lambda_q1': 0.1 * nrm(ks[14], (DEPTH, DIFF_DIM)),
        'lambda_k1': 0.1 * nrm(ks[15], (DEPTH, DIFF_DIM)),
        'lambda_q2': 0.1 * nrm(ks[16], (DEPTH, DIFF_DIM)),
        'lambda_k2': 0.1 * nrm(ks[17], (DEPTH, DIFF_DIM)),
        'subln_g': 1.0 + 0.01 * nrm(ks[18], (DEPTH, HEAD_DIM)),
        'w_fourier': nrm(ks[19], (DEPTH, WIDTH_C, WIDTH_C)) * WIDTH_C ** -0.5,
        'w_out': nrm(ks[20], (DEPTH, MIX_WIDTH, D_MODEL)) * MIX_WIDTH ** -0.5,
    }


def reference(x_prompt, x_sample, cache_attn_a, cache_attn_b, c, c_ctx,
              norm_g, w_mod, b_mod, w_in, q_norm_a, k_norm_a, q_norm_b, k_norm_b,
              lambda_q1, lambda_k1, lambda_q2, lambda_k2, subln_g, w_fourier, w_out):
    y_prompt = x_prompt
    kv_a_layers, kv_b_layers = [], []
    for l in range(DEPTH):
        shift, scale, gate = modulation(c_ctx, w_mod[l], b_mod[l])
        y_prompt, kv_a, kv_b = mixer_layer(
            y_prompt, shift, scale, gate, norm_g[l], w_in[l],
            q_norm_a[l], k_norm_a[l], q_norm_b[l], k_norm_b[l],
            lambda_q1[l], lambda_k1[l], lambda_q2[l], lambda_k2[l],
            subln_g[l], w_fourier[l], w_out[l], l, None, None, None, None)
        kv_a_layers.append(kv_a)
        kv_b_layers.append(kv_b)
    new_attn_a = jnp.stack(kv_a_layers, axis=1)
    new_attn_b = jnp.stack(kv_b_layers, axis=1)

    n_lat = x_sample.shape[1]
    angs_a = axial_angles(n_lat, HEAD_DIM)
    angs_b = axial_angles(n_lat, DIFF_DIM)
    y_sample = x_sample
    for l in range(DEPTH):
        shift, scale, gate = modulation(c, w_mod[l], b_mod[l])
        y_sample, _, _ = mixer_layer(
            y_sample, shift[:, None, :], scale[:, None, :], gate[:, None, :],
            norm_g[l], w_in[l], q_norm_a[l], k_norm_a[l], q_norm_b[l], k_norm_b[l],
            lambda_q1[l], lambda_k1[l], lambda_q2[l], lambda_k2[l],
            subln_g[l], w_fourier[l], w_out[l], l, angs_a, angs_b,
            cache_attn_a[:, l], cache_attn_b[:, l])
    return (y_prompt, y_sample, new_attn_a, new_attn_b)
```

```cpp
#include <hip/hip_runtime.h>
#include <hip/hip_cooperative_groups.h>
#include <stdint.h>
#include <cstdio>
namespace cg = cooperative_groups;

#ifndef COOP
#define COOP 0
#endif

typedef unsigned short bf16_t;
typedef short bf16x8 __attribute__((ext_vector_type(8)));
typedef float f32x16 __attribute__((ext_vector_type(16)));
typedef uint32_t u32x4 __attribute__((ext_vector_type(4)));
#define DEVI __device__ __forceinline__

constexpr int NTOK = 12288, NCTX = 8192, DM = 1024, N1 = 3072;
constexpr int NTHREADS = 256;
constexpr int LDS_BYTES = 73728;
constexpr float EPS = 1e-6f;
constexpr float LOG2E = 1.4426950408889634f;

constexpr size_t OFF_WTIN  = 0;
constexpr size_t OFF_WTOUT = OFF_WTIN  + 2ull * 3072 * 1024 * 2;
constexpr size_t OFF_W12   = OFF_WTOUT + 2ull * 1024 * 1024 * 2;
constexpr size_t OFF_T256  = OFF_W12   + 2ull * 256 * 512 * 4;
constexpr size_t OFF_T1024 = OFF_T256  + 256ull * 512 * 2;
constexpr size_t OFF_ROPEA = OFF_T1024 + 1024ull * 2048 * 2;
constexpr size_t OFF_ROPEB = OFF_ROPEA + 2ull * 1024 * 32 * 4;
constexpr size_t OFF_MOD   = OFF_ROPEB + 2ull * 1024 * 16 * 4;
constexpr size_t OFF_SHW   = OFF_MOD   + 2ull * 5 * 3072 * 4;
constexpr size_t OFF_SSQ   = OFF_SHW   + 2ull * 5 * 3072 * 4;
constexpr size_t OFF_HP    = OFF_SSQ   + 12288ull * 16 * 4;
constexpr size_t OFF_QA    = OFF_HP    + 12288ull * 1024 * 2;
constexpr size_t OFF_KA    = OFF_QA    + 12288ull * 512 * 2;
constexpr size_t OFF_VTA   = OFF_KA    + 2ull * 14336 * 128 * 2;
constexpr size_t OFF_QB    = OFF_VTA   + 2ull * 14336 * 128 * 2;
constexpr size_t OFF_KB    = OFF_QB    + 12288ull * 256 * 2;
constexpr size_t OFF_VTB   = OFF_KB    + 2ull * 14336 * 256 * 2;
constexpr size_t OFF_G     = OFF_VTB   + 2ull * 14336 * 256 * 2;
constexpr size_t OFF_PQT   = OFF_G     + 12288ull * 1024 * 2;
constexpr size_t OFF_MIX   = OFF_PQT   + 12288ull * 512 * 2;
constexpr size_t OFF_Y1    = OFF_MIX   + 12288ull * 1024 * 2;
constexpr size_t WS_END    = OFF_Y1    + 12288ull * 1024 * 4;

constexpr size_t KA_L = 14336ull * 128, KB_L = 14336ull * 256;

struct Params {
  const float *x_prompt, *x_sample, *cache_a, *cache_b, *c, *c_ctx, *norm_g, *w_mod, *b_mod, *w_in,
      *qn_a, *kn_a, *qn_b, *kn_b, *lq1, *lk1, *lq2, *lk2, *subln_g, *w_c, *w_out;
  float* out;
  char* ws;
};

DEVI uint32_t pk_bf16(float lo, float hi) { uint32_t r; asm("v_cvt_pk_bf16_f32 %0, %1, %2" : "=v"(r) : "v"(lo), "v"(hi)); return r; }
DEVI bf16_t f2bf(float f) { return (bf16_t)(pk_bf16(f, 0.f) & 0xffffu); }
DEVI float bf2f(bf16_t b) { return __uint_as_float(((uint32_t)b) << 16); }
DEVI const float* opq(const float* x) { asm volatile("" : "+s"(x)); return x; }
DEVI float silu(float v) { return v / (1.f + __expf(-v)); }
DEVI f32x16 mfma32(bf16x8 a, bf16x8 b, f32x16 c) { return __builtin_amdgcn_mfma_f32_32x32x16_bf16(a, b, c, 0, 0, 0); }
DEVI void st_bf4(bf16_t* p, float a, float b, float c, float d) { uint2 u; u.x = pk_bf16(a, b); u.y = pk_bf16(c, d); *(uint2*)p = u; }

DEVI void gemm_core(const bf16_t* __restrict__ Ag, int lda, const bf16_t* __restrict__ Bg, int ldb, int K,
                    f32x16 (&acc)[2][2], char* lds) {
  const int t = threadIdx.x, lane = t & 63, wave = t >> 6, wm = wave >> 1, wn = wave & 1;
  const int lr = lane & 31, h = lane >> 5;
  const int c = t & 7, r0 = t >> 3;
#pragma unroll
  for (int a = 0; a < 2; ++a)
#pragma unroll
    for (int b = 0; b < 2; ++b)
#pragma unroll
      for (int i = 0; i < 16; ++i) acc[a][b][i] = 0.f;
  uint4 ra0, ra1, ra2, ra3, rb0, rb1, rb2, rb3;
  const bf16_t* ap = Ag + (size_t)r0 * lda + c * 8;
  const bf16_t* bp = Bg + (size_t)r0 * ldb + c * 8;
  const int nk = K >> 6;
#define GLOAD(KO) { ra0 = *(const uint4*)(ap + (KO)); ra1 = *(const uint4*)(ap + (size_t)32 * lda + (KO)); ra2 = *(const uint4*)(ap + (size_t)64 * lda + (KO)); ra3 = *(const uint4*)(ap + (size_t)96 * lda + (KO)); \
                    rb0 = *(const uint4*)(bp + (KO)); rb1 = *(const uint4*)(bp + (size_t)32 * ldb + (KO)); rb2 = *(const uint4*)(bp + (size_t)64 * ldb + (KO)); rb3 = *(const uint4*)(bp + (size_t)96 * ldb + (KO)); }
#define SWRITE(W) { *(uint4*)(W) = ra0; *(uint4*)((W) + 32 * 144) = ra1; *(uint4*)((W) + 64 * 144) = ra2; *(uint4*)((W) + 96 * 144) = ra3; \
                    *(uint4*)((W) + 18432) = rb0; *(uint4*)((W) + 18432 + 32 * 144) = rb1; *(uint4*)((W) + 18432 + 64 * 144) = rb2; *(uint4*)((W) + 18432 + 96 * 144) = rb3; }
  GLOAD(0);
  {
    char* w = lds + (r0 * 72 + c * 8) * 2;
    SWRITE(w);
  }
  __syncthreads();
  for (int kt = 0; kt < nk; ++kt) {
    if (kt + 1 < nk) GLOAD((kt + 1) * 64);
    const char* sA = lds + (kt & 1) * 36864;
    const char* sB = sA + 18432;
#pragma unroll
    for (int ks = 0; ks < 4; ++ks) {
      bf16x8 fa[2], fb[2];
#pragma unroll
      for (int j = 0; j < 2; ++j) {
        fb[j] = *(const bf16x8*)(sA + ((wm * 64 + j * 32 + lr) * 72 + ks * 16 + h * 8) * 2);
        fa[j] = *(const bf16x8*)(sB + ((wn * 64 + j * 32 + lr) * 72 + ks * 16 + h * 8) * 2);
      }
#pragma unroll
      for (int tn = 0; tn < 2; ++tn)
#pragma unroll
        for (int tm = 0; tm < 2; ++tm) acc[tn][tm] = mfma32(fa[tn], fb[tm], acc[tn][tm]);
    }
    if (kt + 1 < nk) {
      char* w = lds + ((kt + 1) & 1) * 36864 + (r0 * 72 + c * 8) * 2;
      SWRITE(w);
    }
    __syncthreads();
  }
}

DEVI void g1_tile(const Params& p, int l, int mt, int nt, char* lds) {
  const int m0 = mt * 128, n0 = nt * 128;
  const bf16_t* HP = (const bf16_t*)(p.ws + OFF_HP);
  const bf16_t* WT = (const bf16_t*)(p.ws + OFF_WTIN) + (size_t)l * 3072 * 1024;
  f32x16 acc[2][2];
  gemm_core(HP + (size_t)m0 * 1024, 1024, WT + (size_t)n0 * 1024, 1024, 1024, acc, lds);

  const int t = threadIdx.x, lane = t & 63, wave = t >> 6, wm = wave >> 1, wn = wave & 1, lr = lane & 31, h = lane >> 5;
  const int nb = n0 + wn * 64;
  const bool lat = m0 >= NCTX;
  const int jb = lat ? ((m0 - NCTX) >> 10) : 0;
  const int cond = lat ? 1 + jb : 0;
  const float* SSQ = (const float*)(p.ws + OFF_SSQ);
  const float* shw = (const float*)(p.ws + OFF_SHW) + (size_t)(l * 5 + cond) * 3072 + nb + h * 4;
  float sw[2][16];
#pragma unroll
  for (int tn = 0; tn < 2; ++tn)
#pragma unroll
    for (int q = 0; q < 4; ++q) { const float4 s4 = *(const float4*)(shw + tn * 32 + q * 8); sw[tn][q * 4 + 0] = s4.x; sw[tn][q * 4 + 1] = s4.y; sw[tn][q * 4 + 2] = s4.z; sw[tn][q * 4 + 3] = s4.w; }

  int type;
  int gcol = 0;
  if (n0 < 512) type = 0; else if (n0 < 640) type = 1; else if (n0 < 768) type = 2;
  else if (n0 < 1280) { type = 3; gcol = nb - 768; }
  else if (n0 < 1536) type = 4; else if (n0 < 1792) type = 5; else if (n0 < 2048) type = 6;
  else if (n0 < 2304) { type = 3; gcol = 512 + nb - 2048; }
  else if (n0 < 2816) type = 7;
  else { type = 3; gcol = 768 + nb - 2816; }

  const float* ropeA = (const float*)(p.ws + OFF_ROPEA);
  const float* ropeB = (const float*)(p.ws + OFF_ROPEB);

#pragma unroll
  for (int tm = 0; tm < 2; ++tm) {
    __builtin_amdgcn_sched_barrier(0);
    const int tok = m0 + wm * 64 + tm * 32 + lr;
    float rstd;
    {
      const float4* sp = (const float4*)(SSQ + (size_t)tok * 16);
      const float4 a = sp[0], b = sp[1], c4 = sp[2], d = sp[3];
      const float ss = ((a.x + a.y) + (a.z + a.w)) + ((b.x + b.y) + (b.z + b.w)) + ((c4.x + c4.y) + (c4.z + c4.w)) + ((d.x + d.y) + (d.z + d.w));
      rstd = rsqrtf(ss * (1.f / 1024.f) + EPS);
    }
    float v[2][16];
#pragma unroll
    for (int tn = 0; tn < 2; ++tn)
#pragma unroll
      for (int i = 0; i < 16; ++i) v[tn][i] = rstd * acc[tn][tm][i] + sw[tn][i];

    int s, bq, Lk, krow; size_t vbA, vbB, pqb; int S;
    if (!lat) { bq = tok >> 8; s = tok & 255; Lk = 256; krow = tok; vbA = (size_t)bq * 32768; vbB = (size_t)bq * 65536; pqb = (size_t)bq * 131072; S = 256; }
    else { bq = jb; s = (tok - NCTX) & 1023; Lk = 1536; krow = NCTX + jb * 1536 + s; vbA = 1048576 + (size_t)jb * 196608; vbB = 2097152 + (size_t)jb * 393216; pqb = 32ull * 131072 + (size_t)jb * 524288; S = 1024; }

    if (type == 3) {
      bf16_t* G = (bf16_t*)(p.ws + OFF_G) + (size_t)tok * 1024 + gcol + h * 4;
#pragma unroll
      for (int tn = 0; tn < 2; ++tn)
#pragma unroll
        for (int q = 0; q < 4; ++q) st_bf4(G + tn * 32 + q * 8, silu(v[tn][q * 4]), silu(v[tn][q * 4 + 1]), silu(v[tn][q * 4 + 2]), silu(v[tn][q * 4 + 3]));
    } else if (type == 0 || type == 1) {
      float ss = 0.f;
#pragma unroll
      for (int tn = 0; tn < 2; ++tn)
#pragma unroll
        for (int i = 0; i < 16; ++i) ss += v[tn][i] * v[tn][i];
      ss += __shfl_xor(ss, 32);
      const float r = rsqrtf(ss * (1.f / 64.f) + EPS);
      const float* gpa = opq(p.qn_a); const float* gpb = opq(p.kn_a);
      const float* gp = (type == 0 ? gpa : gpb) + l * 64 + h * 4;
#pragma unroll
      for (int tn = 0; tn < 2; ++tn)
#pragma unroll
        for (int q = 0; q < 4; ++q) { const float4 g4 = *(const float4*)(gp + tn * 32 + q * 8); v[tn][q * 4] *= r * g4.x; v[tn][q * 4 + 1] *= r * g4.y; v[tn][q * 4 + 2] *= r * g4.z; v[tn][q * 4 + 3] *= r * g4.w; }
      if (type == 1 && !lat) {
        const int kvh = wn;
        float* o = p.out + 12582912ull + ((((size_t)(bq * 2 + l) * 256 + s) * 2 + 0) * 2 + kvh) * 64 + h * 4;
#pragma unroll
        for (int tn = 0; tn < 2; ++tn)
#pragma unroll
          for (int q = 0; q < 4; ++q) *(float4*)(o + tn * 32 + q * 8) = make_float4(v[tn][q * 4], v[tn][q * 4 + 1], v[tn][q * 4 + 2], v[tn][q * 4 + 3]);
      }
      if (lat) {
        const float* cp = ropeA + (size_t)s * 32 + h * 4;
        const float* sp = cp + 1024 * 32;
#pragma unroll
        for (int tn = 0; tn < 2; ++tn)
#pragma unroll
          for (int q = 0; q < 2; ++q) {
            const float4 c4 = *(const float4*)(cp + tn * 16 + q * 8), s4 = *(const float4*)(sp + tn * 16 + q * 8);
            const float cc[4] = {c4.x, c4.y, c4.z, c4.w}, sn[4] = {s4.x, s4.y, s4.z, s4.w};
#pragma unroll
            for (int e = 0; e < 4; ++e) { const float x1 = v[tn][q * 4 + e], x2 = v[tn][(q + 2) * 4 + e]; v[tn][q * 4 + e] = x1 * cc[e] - x2 * sn[e]; v[tn][(q + 2) * 4 + e] = x1 * sn[e] + x2 * cc[e]; }
          }
      }
      if (type == 0) {
        const float sc = 0.125f * LOG2E;
        bf16_t* Q = (bf16_t*)(p.ws + OFF_QA) + (size_t)tok * 512 + nb + h * 4;
#pragma unroll
        for (int tn = 0; tn < 2; ++tn)
#pragma unroll
          for (int q = 0; q < 4; ++q) st_bf4(Q + tn * 32 + q * 8, v[tn][q * 4] * sc, v[tn][q * 4 + 1] * sc, v[tn][q * 4 + 2] * sc, v[tn][q * 4 + 3] * sc);
      } else {
        bf16_t* Kp = (bf16_t*)(p.ws + OFF_KA) + (size_t)l * KA_L + (size_t)krow * 128 + wn * 64 + h * 4;
#pragma unroll
        for (int tn = 0; tn < 2; ++tn)
#pragma unroll
          for (int q = 0; q < 4; ++q) st_bf4(Kp + tn * 32 + q * 8, v[tn][q * 4], v[tn][q * 4 + 1], v[tn][q * 4 + 2], v[tn][q * 4 + 3]);
      }
    } else if (type == 2) {
      const int kvh = wn;
      if (!lat) {
        float* o = p.out + 12582912ull + ((((size_t)(bq * 2 + l) * 256 + s) * 2 + 1) * 2 + kvh) * 64 + h * 4;
#pragma unroll
        for (int tn = 0; tn < 2; ++tn)
#pragma unroll
          for (int q = 0; q < 4; ++q) *(float4*)(o + tn * 32 + q * 8) = make_float4(v[tn][q * 4], v[tn][q * 4 + 1], v[tn][q * 4 + 2], v[tn][q * 4 + 3]);
      }
      bf16_t* Vt = (bf16_t*)(p.ws + OFF_VTA) + (size_t)l * KA_L + vbA + (size_t)(kvh * 64 + h * 4) * Lk + s;
#pragma unroll
      for (int tn = 0; tn < 2; ++tn)
#pragma unroll
        for (int i = 0; i < 16; ++i) Vt[(size_t)(tn * 32 + (i >> 2) * 8 + (i & 3)) * Lk] = f2bf(v[tn][i]);
    } else if (type == 4 || type == 5) {
      const int hb = (nb - (type == 4 ? 1280 : 1536)) >> 6;
      const float* gpa = opq(p.qn_b); const float* gpb = opq(p.kn_b);
      const float* gp = (type == 4 ? gpa : gpb) + l * 32 + h * 4;
#pragma unroll
      for (int tn = 0; tn < 2; ++tn) {
        float ss = 0.f;
#pragma unroll
        for (int i = 0; i < 16; ++i) ss += v[tn][i] * v[tn][i];
        ss += __shfl_xor(ss, 32);
        const float r = rsqrtf(ss * (1.f / 32.f) + EPS);
#pragma unroll
        for (int q = 0; q < 4; ++q) { const float4 g4 = *(const float4*)(gp + q * 8); v[tn][q * 4] *= r * g4.x; v[tn][q * 4 + 1] *= r * g4.y; v[tn][q * 4 + 2] *= r * g4.z; v[tn][q * 4 + 3] *= r * g4.w; }
      }
      if (type == 5 && !lat) {
        float* o = p.out + 16777216ull + ((((size_t)(bq * 2 + l) * 256 + s) * 2 + 0) * 4 + hb) * 64 + h * 4;
#pragma unroll
        for (int tn = 0; tn < 2; ++tn)
#pragma unroll
          for (int q = 0; q < 4; ++q) *(float4*)(o + tn * 32 + q * 8) = make_float4(v[tn][q * 4], v[tn][q * 4 + 1], v[tn][q * 4 + 2], v[tn][q * 4 + 3]);
      }
      if (lat) {
        const float* cp = ropeB + (size_t)s * 16 + h * 4;
        const float* sp = cp + 1024 * 16;
#pragma unroll
        for (int hf = 0; hf < 2; ++hf) {
          const float4 c4 = *(const float4*)(cp + hf * 8), s4 = *(const float4*)(sp + hf * 8);
          const float cc[4] = {c4.x, c4.y, c4.z, c4.w}, sn[4] = {s4.x, s4.y, s4.z, s4.w};
#pragma unroll
          for (int tn = 0; tn < 2; ++tn)
#pragma unroll
            for (int e = 0; e < 4; ++e) { const float x1 = v[tn][(2 * hf) * 4 + e], x2 = v[tn][(2 * hf + 1) * 4 + e]; v[tn][(2 * hf) * 4 + e] = x1 * cc[e] - x2 * sn[e]; v[tn][(2 * hf + 1) * 4 + e] = x1 * sn[e] + x2 * cc[e]; }
        }
      }
      if (type == 4) {
        const float sc = 0.17677669529663687f * LOG2E;
        bf16_t* Q = (bf16_t*)(p.ws + OFF_QB) + (size_t)tok * 256 + hb * 64 + h * 4;
#pragma unroll
        for (int tn = 0; tn < 2; ++tn)
#pragma unroll
          for (int q = 0; q < 4; ++q) st_bf4(Q + tn * 32 + q * 8, v[tn][q * 4] * sc, v[tn][q * 4 + 1] * sc, v[tn][q * 4 + 2] * sc, v[tn][q * 4 + 3] * sc);
      } else {
        bf16_t* Kp = (bf16_t*)(p.ws + OFF_KB) + (size_t)l * KB_L + (size_t)krow * 256 + hb * 64 + h * 4;
#pragma unroll
        for (int tn = 0; tn < 2; ++tn)
#pragma unroll
          for (int q = 0; q < 4; ++q) st_bf4(Kp + tn * 32 + q * 8, v[tn][q * 4], v[tn][q * 4 + 1], v[tn][q * 4 + 2], v[tn][q * 4 + 3]);
      }
    } else if (type == 6) {
      const int hb = (nb - 1792) >> 6;
      if (!lat) {
        float* o = p.out + 16777216ull + ((((size_t)(bq * 2 + l) * 256 + s) * 2 + 1) * 4 + hb) * 64 + h * 4;
#pragma unroll
        for (int tn = 0; tn < 2; ++tn)
#pragma unroll
          for (int q = 0; q < 4; ++q) *(float4*)(o + tn * 32 + q * 8) = make_float4(v[tn][q * 4], v[tn][q * 4 + 1], v[tn][q * 4 + 2], v[tn][q * 4 + 3]);
      }
      bf16_t* Vt = (bf16_t*)(p.ws + OFF_VTB) + (size_t)l * KB_L + vbB + (size_t)(hb * 64 + h * 4) * Lk + s;
#pragma unroll
      for (int tn = 0; tn < 2; ++tn)
#pragma unroll
        for (int i = 0; i < 16; ++i) Vt[(size_t)(tn * 32 + (i >> 2) * 8 + (i & 3)) * Lk] = f2bf(v[tn][i]);
    } else {
      const int nn = nb - 2304, comp = nn >> 8, ch = (nn & 255) + h * 4;
      bf16_t* PQ = (bf16_t*)(p.ws + OFF_PQT) + pqb + (size_t)ch * (2 * S) + comp * S + s;
#pragma unroll
      for (int tn = 0; tn < 2; ++tn)
#pragma unroll
        for (int i = 0; i < 16; ++i) PQ[(size_t)(tn * 32 + (i >> 2) * 8 + (i & 3)) * (2 * S)] = f2bf(v[tn][i]);
    }
  }
}

DEVI void g2_tile(const Params& p, int l, int mt, int nt, char* lds) {
  const int m0 = mt * 128, n0 = nt * 128;
  const bf16_t* MIX = (const bf16_t*)(p.ws + OFF_MIX);
  const bf16_t* WT = (const bf16_t*)(p.ws + OFF_WTOUT) + (size_t)l * 1024 * 1024;
  f32x16 acc[2][2];
  gemm_core(MIX + (size_t)m0 * 1024, 1024, WT + (size_t)n0 * 1024, 1024, 1024, acc, lds);

  const int t = threadIdx.x, lane = t & 63, wave = t >> 6, wm = wave >> 1, wn = wave & 1, lr = lane & 31, h = lane >> 5;
  const int nb = n0 + wn * 64 + h * 4;
  const bool lat = m0 >= NCTX;
  const int cond = lat ? 1 + ((m0 - NCTX) >> 10) : 0;
  const float* MOD = (const float*)(p.ws + OFF_MOD);
  const float* gate = MOD + (size_t)(l * 5 + cond) * 3072 + 2048 + nb;
  float gt[2][16], gs[2][16];
#pragma unroll
  for (int tn = 0; tn < 2; ++tn)
#pragma unroll
    for (int q = 0; q < 4; ++q) {
      const float4 g4 = *(const float4*)(gate + tn * 32 + q * 8);
      gt[tn][q * 4] = g4.x; gt[tn][q * 4 + 1] = g4.y; gt[tn][q * 4 + 2] = g4.z; gt[tn][q * 4 + 3] = g4.w;
      if (l == 0) {
        const float4 ng = *(const float4*)(p.norm_g + 1024 + nb + tn * 32 + q * 8);
        const float4 sc = *(const float4*)(MOD + (size_t)(5 + cond) * 3072 + 1024 + nb + tn * 32 + q * 8);
        gs[tn][q * 4] = ng.x * (1.f + sc.x); gs[tn][q * 4 + 1] = ng.y * (1.f + sc.y); gs[tn][q * 4 + 2] = ng.z * (1.f + sc.z); gs[tn][q * 4 + 3] = ng.w * (1.f + sc.w);
      }
    }
#pragma unroll
  for (int tm = 0; tm < 2; ++tm) {
    const int tok = m0 + wm * 64 + tm * 32 + lr;
    const float* xin;
    float* yout;
    if (l == 0) { const float* xa = opq(p.x_prompt); const float* xb = opq(p.x_sample); xin = (tok < NCTX ? xa + (size_t)tok * 1024 : xb + (size_t)(tok - NCTX) * 1024); yout = (float*)(p.ws + OFF_Y1) + (size_t)tok * 1024; }
    else { xin = (const float*)(p.ws + OFF_Y1) + (size_t)tok * 1024; yout = p.out + (size_t)tok * 1024; }
    float ss = 0.f;
#pragma unroll
    for (int tn = 0; tn < 2; ++tn)
#pragma unroll
      for (int q = 0; q < 4; ++q) {
        const float4 x4 = *(const float4*)(xin + nb + tn * 32 + q * 8);
        float4 y;
        y.x = x4.x + gt[tn][q * 4] * acc[tn][tm][q * 4];
        y.y = x4.y + gt[tn][q * 4 + 1] * acc[tn][tm][q * 4 + 1];
        y.z = x4.z + gt[tn][q * 4 + 2] * acc[tn][tm][q * 4 + 2];
        y.w = x4.w + gt[tn][q * 4 + 3] * acc[tn][tm][q * 4 + 3];
        *(float4*)(yout + nb + tn * 32 + q * 8) = y;
        if (l == 0) {
          ss += y.x * y.x + y.y * y.y + y.z * y.z + y.w * y.w;
          st_bf4((bf16_t*)(p.ws + OFF_HP) + (size_t)tok * 1024 + nb + tn * 32 + q * 8, y.x * gs[tn][q * 4], y.y * gs[tn][q * 4 + 1], y.z * gs[tn][q * 4 + 2], y.w * gs[tn][q * 4 + 3]);
        }
      }
    if (l == 0) {
      ss += __shfl_xor(ss, 32);
      if (h == 0) ((float*)(p.ws + OFF_SSQ))[(size_t)tok * 16 + nt * 2 + wn] = ss;
    }
  }
}

DEVI void fourier_tile(const Params& p, int tok_seq0, int S, size_t pqb, int mt, int nt, char* lds) {
  const bf16_t* T = (const bf16_t*)(p.ws + (S == 256 ? OFF_T256 : OFF_T1024));
  const bf16_t* PQ = (const bf16_t*)(p.ws + OFF_PQT) + pqb;
  f32x16 acc[2][2];
  gemm_core(T + (size_t)(mt * 128) * (2 * S), 2 * S, PQ + (size_t)(nt * 128) * (2 * S), 2 * S, 2 * S, acc, lds);
  const int t = threadIdx.x, lane = t & 63, wave = t >> 6, wm = wave >> 1, wn = wave & 1, lr = lane & 31, h = lane >> 5;
#pragma unroll
  for (int tm = 0; tm < 2; ++tm) {
    const int tok = tok_seq0 + mt * 128 + wm * 64 + tm * 32 + lr;
    const size_t col = (size_t)tok * 1024 + 768 + nt * 128 + wn * 64 + h * 4;
    const bf16_t* G = (const bf16_t*)(p.ws + OFF_G) + col;
    bf16_t* M = (bf16_t*)(p.ws + OFF_MIX) + col;
#pragma unroll
    for (int tn = 0; tn < 2; ++tn)
#pragma unroll
      for (int q = 0; q < 4; ++q) {
        const uint2 g = *(const uint2*)(G + tn * 32 + q * 8);
        st_bf4(M + tn * 32 + q * 8, acc[tn][tm][q * 4] * __uint_as_float(g.x << 16), acc[tn][tm][q * 4 + 1] * __uint_as_float(g.x & 0xffff0000u),
               acc[tn][tm][q * 4 + 2] * __uint_as_float(g.y << 16), acc[tn][tm][q * 4 + 3] * __uint_as_float(g.y & 0xffff0000u));
      }
  }
}

template <int NC>
DEVI void attn_unit(const Params& p, int l, int tok0, int head, char* lds) {
  const int t = threadIdx.x, lane = t & 63, wave = t >> 6, lr = lane & 31, h = lane >> 5;
  const bool lat = tok0 >= NCTX;
  int Lk, krow0; size_t vbase;
  if (!lat) { const int b = tok0 >> 8; Lk = 256; krow0 = b * 256; vbase = (NC == 1) ? (size_t)b * 32768 : (size_t)b * 65536; }
  else { const int j = (tok0 - NCTX) >> 10; Lk = 1536; krow0 = NCTX + j * 1536; vbase = (NC == 1) ? 1048576 + (size_t)j * 196608 : 2097152 + (size_t)j * 393216; }
  const bf16_t *Kg, *Vg, *Qg; int kst, qst;
  if (NC == 1) {
    const int kvh = head >> 2;
    Kg = (const bf16_t*)(p.ws + OFF_KA) + (size_t)l * KA_L + (size_t)krow0 * 128 + kvh * 64; kst = 128;
    Vg = (const bf16_t*)(p.ws + OFF_VTA) + (size_t)l * KA_L + vbase + (size_t)kvh * 64 * Lk;
    Qg = (const bf16_t*)(p.ws + OFF_QA) + (size_t)tok0 * 512 + head * 64; qst = 512;
  } else {
    Kg = (const bf16_t*)(p.ws + OFF_KB) + (size_t)l * KB_L + (size_t)krow0 * 256 + head * 64; kst = 256;
    Vg = (const bf16_t*)(p.ws + OFF_VTB) + (size_t)l * KB_L + vbase + (size_t)head * 64 * Lk;
    Qg = (const bf16_t*)(p.ws + OFF_QB) + (size_t)tok0 * 256 + head * 64; qst = 256;
  }
  bf16x8 qf[4];
  {
    const bf16_t* qp = Qg + (size_t)(wave * 32 + lr) * qst + h * 8;
#pragma unroll
    for (int j = 0; j < 4; ++j) qf[j] = *(const bf16x8*)(qp + j * 16);
  }
  f32x16 O[NC][2];
  float mrun[NC], lsum[NC];
#pragma unroll
  for (int c = 0; c < NC; ++c) {
    mrun[c] = -INFINITY; lsum[c] = 0.f;
#pragma unroll
    for (int dt = 0; dt < 2; ++dt)
#pragma unroll
      for (int i = 0; i < 16; ++i) O[c][dt][i] = 0.f;
  }
  const int c8 = t & 7, r0 = t >> 3;
  uint4 rk0, rk1, rv0, rv1;
  const bf16_t* kp = Kg + (size_t)r0 * kst + c8 * 8;
  const bf16_t* vp = Vg + (size_t)r0 * Lk + c8 * 8;
  const int nkt = Lk >> 6;
  rk0 = *(const uint4*)(kp); rk1 = *(const uint4*)(kp + (size_t)32 * kst);
  rv0 = *(const uint4*)(vp); rv1 = *(const uint4*)(vp + (size_t)32 * Lk);
  {
    char* w = lds + (r0 * 72 + c8 * 8) * 2;
    *(uint4*)(w) = rk0; *(uint4*)(w + 32 * 144) = rk1; *(uint4*)(w + 9216) = rv0; *(uint4*)(w + 9216 + 32 * 144) = rv1;
  }
  __syncthreads();
  for (int kt = 0; kt < nkt; ++kt) {
    if (kt + 1 < nkt) {
      rk0 = *(const uint4*)(kp + (size_t)((kt + 1) * 64) * kst); rk1 = *(const uint4*)(kp + (size_t)((kt + 1) * 64 + 32) * kst);
      rv0 = *(const uint4*)(vp + (kt + 1) * 64); rv1 = *(const uint4*)(vp + (size_t)32 * Lk + (kt + 1) * 64);
    }
    const char* sK = lds + (kt & 1) * 18432;
    const char* sV = sK + 9216;
#pragma unroll
    for (int kk = 0; kk < 2; ++kk) {
#pragma unroll
      for (int c = 0; c < NC; ++c) {
        asm volatile("" ::: "memory");
        bf16x8 pf[2];
        f32x16 S;
#pragma unroll
        for (int i = 0; i < 16; ++i) S[i] = 0.f;
#pragma unroll
        for (int jj = 0; jj < 4 / NC; ++jj) {
          const int j = c * (4 / NC) + jj;
          const bf16x8 kf = *(const bf16x8*)(sK + ((kk * 32 + lr) * 72 + j * 16 + h * 8) * 2);
          S = mfma32(kf, qf[j], S);
        }
        float mx = S[0];
#pragma unroll
        for (int i = 1; i < 16; ++i) mx = fmaxf(mx, S[i]);
        mx = fmaxf(mx, __shfl_xor(mx, 32));
        const float mnew = fmaxf(mrun[c], mx);
        const float alpha = __builtin_amdgcn_exp2f(mrun[c] - mnew);
        mrun[c] = mnew;
        float ps = 0.f;
#pragma unroll
        for (int i = 0; i < 16; ++i) { S[i] = __builtin_amdgcn_exp2f(S[i] - mnew); ps += S[i]; }
        lsum[c] = lsum[c] * alpha + ps;
#pragma unroll
        for (int dt = 0; dt < 2; ++dt)
#pragma unroll
          for (int i = 0; i < 16; ++i) O[c][dt][i] *= alpha;
#pragma unroll
        for (int s2 = 0; s2 < 2; ++s2) {
          u32x4 u;
          u.x = pk_bf16(S[8 * s2 + 0], S[8 * s2 + 1]); u.y = pk_bf16(S[8 * s2 + 2], S[8 * s2 + 3]);
          u.z = pk_bf16(S[8 * s2 + 4], S[8 * s2 + 5]); u.w = pk_bf16(S[8 * s2 + 6], S[8 * s2 + 7]);
          pf[s2] = __builtin_bit_cast(bf16x8, u);
        }
#pragma unroll
        for (int dt = 0; dt < 2; ++dt)
#pragma unroll
          for (int s2 = 0; s2 < 2; ++s2) {
            const char* va = sV + ((dt * 32 + lr) * 72 + kk * 32 + 16 * s2 + 4 * h) * 2;
            const uint2 v0 = *(const uint2*)va, v1 = *(const uint2*)(va + 16);
            u32x4 u; u.x = v0.x; u.y = v0.y; u.z = v1.x; u.w = v1.y;
            O[c][dt] = mfma32(__builtin_bit_cast(bf16x8, u), pf[s2], O[c][dt]);
          }
      }
    }
    if (kt + 1 < nkt) {
      char* w = lds + ((kt + 1) & 1) * 18432 + (r0 * 72 + c8 * 8) * 2;
      *(uint4*)(w) = rk0; *(uint4*)(w + 32 * 144) = rk1; *(uint4*)(w + 9216) = rv0; *(uint4*)(w + 9216 + 32 * 144) = rv1;
    }
    __syncthreads();
  }
  const int tok = tok0 + wave * 32 + lr;
  float inv[NC];
#pragma unroll
  for (int c = 0; c < NC; ++c) { const float lt = lsum[c] + __shfl_xor(lsum[c], 32); inv[c] = 1.f / lt; }
  if (NC == 1) {
    const size_t col = (size_t)tok * 1024 + head * 64 + h * 4;
    const bf16_t* G = (const bf16_t*)(p.ws + OFF_G) + col;
    bf16_t* M = (bf16_t*)(p.ws + OFF_MIX) + col;
#pragma unroll
    for (int dt = 0; dt < 2; ++dt)
#pragma unroll
      for (int q = 0; q < 4; ++q) {
        const uint2 g = *(const uint2*)(G + dt * 32 + q * 8);
        st_bf4(M + dt * 32 + q * 8, O[0][dt][q * 4] * inv[0] * __uint_as_float(g.x << 16), O[0][dt][q * 4 + 1] * inv[0] * __uint_as_float(g.x & 0xffff0000u),
               O[0][dt][q * 4 + 2] * inv[0] * __uint_as_float(g.y << 16), O[0][dt][q * 4 + 3] * inv[0] * __uint_as_float(g.y & 0xffff0000u));
      }
  } else {
    float d1 = 0.f, d2 = 0.f;
    for (int i = 0; i < 32; ++i) { d1 += p.lq1[l * 32 + i] * p.lk1[l * 32 + i]; d2 += p.lq2[l * 32 + i] * p.lk2[l * 32 + i]; }
    const float lam_init = (l == 0) ? 0.2f : 0.35550907f;
    const float lam = expf(d1) - expf(d2) + lam_init;
    float o[2][16];
    float ss = 0.f;
#pragma unroll
    for (int dt = 0; dt < 2; ++dt)
#pragma unroll
      for (int i = 0; i < 16; ++i) { o[dt][i] = O[0][dt][i] * inv[0] - lam * (O[NC - 1][dt][i] * inv[NC - 1]); ss += o[dt][i] * o[dt][i]; }
    ss += __shfl_xor(ss, 32);
    const float r = rsqrtf(ss * (1.f / 64.f) + EPS) * (1.f - lam_init);
    const size_t col = (size_t)tok * 1024 + 512 + head * 64 + h * 4;
    const bf16_t* G = (const bf16_t*)(p.ws + OFF_G) + col;
    bf16_t* M = (bf16_t*)(p.ws + OFF_MIX) + col;
    const float* sg = p.subln_g + l * 64 + h * 4;
#pragma unroll
    for (int dt = 0; dt < 2; ++dt)
#pragma unroll
      for (int q = 0; q < 4; ++q) {
        const uint2 g = *(const uint2*)(G + dt * 32 + q * 8);
        const float4 s4 = *(const float4*)(sg + dt * 32 + q * 8);
        st_bf4(M + dt * 32 + q * 8, o[dt][q * 4] * r * s4.x * __uint_as_float(g.x << 16), o[dt][q * 4 + 1] * r * s4.y * __uint_as_float(g.x & 0xffff0000u),
               o[dt][q * 4 + 2] * r * s4.z * __uint_as_float(g.y << 16), o[dt][q * 4 + 3] * r * s4.w * __uint_as_float(g.y & 0xffff0000u));
      }
  }
}

DEVI void att_phase_unit(const Params& p, int l, int u, char* lds) {
  if (u < 128) { const int j = u >> 5, head = (u >> 3) & 3, qb = u & 7; attn_unit<2>(p, l, NCTX + j * 1024 + qb * 128, head, lds); return; }
  u -= 128;
  if (u < 256) { const int j = u >> 6, head = (u >> 3) & 7, qb = u & 7; attn_unit<1>(p, l, NCTX + j * 1024 + qb * 128, head, lds); return; }
  u -= 256;
  if (u < 64) { const int j = u >> 4, mt = (u >> 1) & 7, nt = u & 1; fourier_tile(p, NCTX + j * 1024, 1024, 32ull * 131072 + (size_t)j * 524288, mt, nt, lds); return; }
  u -= 64;
  if (u < 256) { const int b = u >> 3, head = (u >> 1) & 3, qb = u & 1; attn_unit<2>(p, l, b * 256 + qb * 128, head, lds); return; }
  u -= 256;
  if (u < 512) { const int b = u >> 4, head = (u >> 1) & 7, qb = u & 1; attn_unit<1>(p, l, b * 256 + qb * 128, head, lds); return; }
  u -= 512;
  { const int b = u >> 2, mt = (u >> 1) & 1, nt = u & 1; fourier_tile(p, b * 256, 256, (size_t)b * 131072, mt, nt, lds); }
}
constexpr int ATT_UNITS = 128 + 256 + 64 + 256 + 512 + 128;

DEVI void p0a(const Params& p, char* lds) {
  const int t = threadIdx.x, nb = gridDim.x, bid = blockIdx.x;
  float* lf = (float*)lds;
  {
    float* sl = lf;
    float* red = lf + 5120;
    bool loaded = false;
    for (int it = bid; it < 96; it += nb) {
      if (!loaded) {
        for (int i = t; i < 5120; i += NTHREADS) { const int cnd = i >> 10, k = i & 1023; const float* ca = opq(p.c_ctx); const float* cb = opq(p.c); const float v = cnd == 0 ? ca[k] : cb[(cnd - 1) * 1024 + k]; sl[i] = v / (1.f + expf(-v)); }
        loaded = true;
        __syncthreads();
      }
      const int l = it / 48, cb = it % 48, c4 = t & 15, kg = t >> 4;
      float a[5][4];
#pragma unroll
      for (int cnd = 0; cnd < 5; ++cnd)
#pragma unroll
        for (int e = 0; e < 4; ++e) a[cnd][e] = 0.f;
      const float* wp = p.w_mod + (size_t)l * 1024 * 3072 + cb * 64 + c4 * 4;
      for (int i = 0; i < 64; ++i) {
        const int k = kg + 16 * i;
        const float4 w = *(const float4*)(wp + (size_t)k * 3072);
#pragma unroll
        for (int cnd = 0; cnd < 5; ++cnd) { const float s = sl[cnd * 1024 + k]; a[cnd][0] += s * w.x; a[cnd][1] += s * w.y; a[cnd][2] += s * w.z; a[cnd][3] += s * w.w; }
      }
#pragma unroll
      for (int cnd = 0; cnd < 5; ++cnd)
#pragma unroll
        for (int e = 0; e < 4; ++e) red[(kg * 5 + cnd) * 64 + c4 * 4 + e] = a[cnd][e];
      __syncthreads();
      for (int o = t; o < 320; o += NTHREADS) {
        const int cnd = o >> 6, col = o & 63;
        float s = p.b_mod[l * 3072 + cb * 64 + col];
        for (int g = 0; g < 16; ++g) s += red[(g * 5 + cnd) * 64 + col];
        ((float*)(p.ws + OFF_MOD))[(size_t)(l * 5 + cnd) * 3072 + cb * 64 + col] = s;
      }
      __syncthreads();
    }
    __syncthreads();
  }
  for (int it = bid; it < 1280 + 512; it += nb) {
    const float* src; bf16_t* dst; int ld;
    if (it < 1280) {
      const int l = it / 640, r = it % 640, nt = r >> 4, kt = r & 15;
      const int sn0 = nt < 36 ? nt * 64 : 2560 + (nt - 36) * 64, dn0 = nt < 36 ? nt * 64 : 2816 + (nt - 36) * 64;
      src = p.w_in + (size_t)l * 1024 * 2816 + (size_t)(kt * 64) * 2816 + sn0; ld = 2816;
      dst = (bf16_t*)(p.ws + OFF_WTIN) + (size_t)l * 3072 * 1024 + (size_t)dn0 * 1024 + kt * 64;
    } else {
      const int q = it - 1280, l = q >> 8, r = q & 255, nt = r >> 4, kt = r & 15;
      src = p.w_out + (size_t)l * 1024 * 1024 + (size_t)(kt * 64) * 1024 + nt * 64; ld = 1024;
      dst = (bf16_t*)(p.ws + OFF_WTOUT) + (size_t)l * 1024 * 1024 + (size_t)(nt * 64) * 1024 + kt * 64;
    }
    {
      const int col = t & 63, rw = t >> 6;
#pragma unroll
      for (int i = 0; i < 16; ++i) lf[(rw + 4 * i) * 65 + col] = src[(size_t)(rw + 4 * i) * ld + col];
    }
    __syncthreads();
    {
      const int n = t >> 2, kc = (t & 3) * 16;
      uint32_t w[8];
#pragma unroll
      for (int j = 0; j < 8; ++j) w[j] = pk_bf16(lf[(kc + 2 * j) * 65 + n], lf[(kc + 2 * j + 1) * 65 + n]);
      uint4* d = (uint4*)(dst + (size_t)n * 1024 + kc);
      d[0] = make_uint4(w[0], w[1], w[2], w[3]); d[1] = make_uint4(w[4], w[5], w[6], w[7]);
    }
    __syncthreads();
  }
  {
    if (t < 64) { lf[t] = cospif((float)t / 32.f); lf[64 + t] = sinpif((float)t / 32.f); }
    __syncthreads();
    for (int gid = bid * NTHREADS + t; gid < 2 * 256 * 512; gid += nb * NTHREADS) {
      const int l = gid >> 17, r = (gid >> 9) & 255, n = gid & 511, comp = n >> 8, nn = n & 255, g = r >> 6, cc = r & 63;
      const float* wc = p.w_c + (size_t)l * 65536 + (size_t)(g * 64) * 256 + nn;
      const float* tb = lf + comp * 64;
      float s = 0.f;
      for (int c2 = 0; c2 < 64; ++c2) s += tb[(cc * c2) & 63] * wc[(size_t)c2 * 256];
      ((float*)(p.ws + OFF_W12))[gid] = s;
    }
    __syncthreads();
  }
  for (int gid = bid * NTHREADS + t; gid < 256 * 512; gid += nb * NTHREADS) {
    const int sp = gid >> 9, k = gid & 511, kk = k & 255, m = (sp * kk) & 255;
    const float ang = (float)m / 128.f;
    const float v = (k < 256 ? cospif(ang) : -sinpif(ang)) * (1.f / 128.f);
    ((bf16_t*)(p.ws + OFF_T256))[gid] = f2bf(v);
  }
  for (int gid = bid * NTHREADS + t; gid < 1024 * 2048; gid += nb * NTHREADS) {
    const int sp = gid >> 11, k = gid & 2047, kk = k & 1023, m = (sp * kk) & 1023;
    const float ang = (float)m / 512.f;
    const float v = (k < 1024 ? cospif(ang) : -sinpif(ang)) * (1.f / 256.f);
    ((bf16_t*)(p.ws + OFF_T1024))[gid] = f2bf(v);
  }
  for (int gid = bid * NTHREADS + t; gid < 1024 * 32; gid += nb * NTHREADS) {
    const int s = gid >> 5, j = gid & 31, f = j & 15;
    const float pos = (float)(j < 16 ? (s >> 6) : (s & 63));
    const float inv = 1.0f / powf(10000.f, (float)f / 16.f);
    const float ang = pos * inv;
    float* R = (float*)(p.ws + OFF_ROPEA);
    R[gid] = cosf(ang); R[1024 * 32 + gid] = sinf(ang);
  }
  for (int gid = bid * NTHREADS + t; gid < 1024 * 16; gid += nb * NTHREADS) {
    const int s = gid >> 4, j = gid & 15, f = j & 7;
    const float pos = (float)(j < 8 ? (s >> 6) : (s & 63));
    const float inv = 1.0f / powf(10000.f, (float)f / 8.f);
    const float ang = pos * inv;
    float* R = (float*)(p.ws + OFF_ROPEB);
    R[gid] = cosf(ang); R[1024 * 16 + gid] = sinf(ang);
  }
  for (int gid = bid * NTHREADS + t; gid < 1048576; gid += nb * NTHREADS) {
    const int d = gid & 63, kvh = (gid >> 6) & 1, which = (gid >> 7) & 1, pp = (gid >> 8) & 511, l = (gid >> 17) & 1, j = gid >> 18;
    const bf16_t v = f2bf(p.cache_a[gid]);
    if (which == 0) ((bf16_t*)(p.ws + OFF_KA))[(size_t)l * KA_L + (size_t)(NCTX + j * 1536 + 1024 + pp) * 128 + kvh * 64 + d] = v;
    else ((bf16_t*)(p.ws + OFF_VTA))[(size_t)l * KA_L + 1048576 + (size_t)j * 196608 + (size_t)(kvh * 64 + d) * 1536 + 1024 + pp] = v;
  }
  for (int gid = bid * NTHREADS + t; gid < 2097152; gid += nb * NTHREADS) {
    const int d = gid & 63, hh = (gid >> 6) & 3, which = (gid >> 8) & 1, pp = (gid >> 9) & 511, l = (gid >> 18) & 1, j = gid >> 19;
    const bf16_t v = f2bf(p.cache_b[gid]);
    if (which == 0) ((bf16_t*)(p.ws + OFF_KB))[(size_t)l * KB_L + (size_t)(NCTX + j * 1536 + 1024 + pp) * 256 + hh * 64 + d] = v;
    else ((bf16_t*)(p.ws + OFF_VTB))[(size_t)l * KB_L + 2097152 + (size_t)j * 393216 + (size_t)(hh * 64 + d) * 1536 + 1024 + pp] = v;
  }
}

DEVI void p0b(const Params& p, char* lds) {
  const int t = threadIdx.x, nb = gridDim.x, bid = blockIdx.x;
  float* lf = (float*)lds;
  for (int it = bid; it < 256; it += nb) {
    const int l = it >> 7, kt = (it >> 3) & 15, ntl = it & 7;
    const float* U = p.w_in + (size_t)l * 1024 * 2816 + (size_t)(kt * 64) * 2816 + 2304;
    const float* W = (const float*)(p.ws + OFF_W12) + (size_t)l * 256 * 512 + ntl * 64;
    float* Us = lf;
    float* Ws = lf + 64 * 33;
    const int tk = t >> 4, tn = t & 15;
    float a[4][4];
#pragma unroll
    for (int i = 0; i < 4; ++i)
#pragma unroll
      for (int j = 0; j < 4; ++j) a[i][j] = 0.f;
    for (int rc = 0; rc < 8; ++rc) {
#pragma unroll
      for (int i = 0; i < 8; ++i) { const int e = t + 256 * i, kk = e >> 5, rr = e & 31; Us[kk * 33 + rr] = U[(size_t)kk * 2816 + rc * 32 + rr]; }
#pragma unroll
      for (int i = 0; i < 8; ++i) { const int e = t + 256 * i, rr = e >> 6, nn = e & 63; Ws[rr * 64 + nn] = W[(size_t)(rc * 32 + rr) * 512 + nn]; }
      __syncthreads();
#pragma unroll 8
      for (int r = 0; r < 32; ++r) {
        const float4 w = *(const float4*)(Ws + r * 64 + tn * 4);
#pragma unroll
        for (int i = 0; i < 4; ++i) { const float u = Us[(tk * 4 + i) * 33 + r]; a[i][0] += u * w.x; a[i][1] += u * w.y; a[i][2] += u * w.z; a[i][3] += u * w.w; }
      }
      __syncthreads();
    }
    bf16_t* dst = (bf16_t*)(p.ws + OFF_WTIN) + (size_t)l * 3072 * 1024 + (size_t)(2304 + ntl * 64 + tn * 4) * 1024 + kt * 64 + tk * 4;
#pragma unroll
    for (int j = 0; j < 4; ++j) st_bf4(dst + (size_t)j * 1024, a[0][j], a[1][j], a[2][j], a[3][j]);
  }
  {
    const int lane = t & 63, wave = t >> 6;
    const float* MOD = (const float*)(p.ws + OFF_MOD);
    for (int row = bid * 4 + wave; row < NTOK; row += nb * 4) {
      const float* xa = opq(p.x_prompt); const float* xb = opq(p.x_sample);
      const float* x = row < NCTX ? xa + (size_t)row * 1024 : xb + (size_t)(row - NCTX) * 1024;
      const int cond = row < NCTX ? 0 : 1 + ((row - NCTX) >> 10);
      const float* sc = MOD + (size_t)cond * 3072 + 1024;
      bf16_t* hp = (bf16_t*)(p.ws + OFF_HP) + (size_t)row * 1024;
      float ss = 0.f;
#pragma unroll
      for (int i = 0; i < 4; ++i) {
        const int k = i * 256 + lane * 4;
        const float4 xv = *(const float4*)(x + k), g = *(const float4*)(p.norm_g + k), s4 = *(const float4*)(sc + k);
        ss += xv.x * xv.x + xv.y * xv.y + xv.z * xv.z + xv.w * xv.w;
        st_bf4(hp + k, xv.x * g.x * (1.f + s4.x), xv.y * g.y * (1.f + s4.y), xv.z * g.z * (1.f + s4.z), xv.w * g.w * (1.f + s4.w));
      }
#pragma unroll
      for (int o = 32; o > 0; o >>= 1) ss += __shfl_xor(ss, o);
      if (lane < 16) ((float*)(p.ws + OFF_SSQ))[(size_t)row * 16 + lane] = lane == 0 ? ss : 0.f;
    }
  }
}

DEVI void p0c(const Params& p) {
  const int t = threadIdx.x, lane = t & 63, wave = t >> 6;
  const float* MOD = (const float*)(p.ws + OFF_MOD);
  for (int idx = blockIdx.x * 4 + wave; idx < 2 * 3072; idx += gridDim.x * 4) {
    const int l = idx / 3072, n = idx % 3072;
    const bf16_t* w = (const bf16_t*)(p.ws + OFF_WTIN) + (size_t)l * 3072 * 1024 + (size_t)n * 1024 + lane * 16;
    const uint4 w0 = *(const uint4*)w, w1 = *(const uint4*)(w + 8);
    float wf[16];
    wf[0] = __uint_as_float(w0.x << 16); wf[1] = __uint_as_float(w0.x & 0xffff0000u); wf[2] = __uint_as_float(w0.y << 16); wf[3] = __uint_as_float(w0.y & 0xffff0000u);
    wf[4] = __uint_as_float(w0.z << 16); wf[5] = __uint_as_float(w0.z & 0xffff0000u); wf[6] = __uint_as_float(w0.w << 16); wf[7] = __uint_as_float(w0.w & 0xffff0000u);
    wf[8] = __uint_as_float(w1.x << 16); wf[9] = __uint_as_float(w1.x & 0xffff0000u); wf[10] = __uint_as_float(w1.y << 16); wf[11] = __uint_as_float(w1.y & 0xffff0000u);
    wf[12] = __uint_as_float(w1.z << 16); wf[13] = __uint_as_float(w1.z & 0xffff0000u); wf[14] = __uint_as_float(w1.w << 16); wf[15] = __uint_as_float(w1.w & 0xffff0000u);
#pragma unroll
    for (int cnd = 0; cnd < 5; ++cnd) {
      const float* sh = MOD + (size_t)(l * 5 + cnd) * 3072 + lane * 16;
      float s = 0.f;
#pragma unroll
      for (int i = 0; i < 4; ++i) { const float4 s4 = *(const float4*)(sh + i * 4); s += s4.x * wf[i * 4] + s4.y * wf[i * 4 + 1] + s4.z * wf[i * 4 + 2] + s4.w * wf[i * 4 + 3]; }
#pragma unroll
      for (int o = 32; o > 0; o >>= 1) s += __shfl_xor(s, o);
      if (lane == 0) ((float*)(p.ws + OFF_SHW))[(size_t)(l * 5 + cnd) * 3072 + n] = s;
    }
  }
}

constexpr int NPHASES = 9;
DEVI void run_phase(const Params& p, int ph, char* lds) {
  if (ph == 0) { p0a(p, lds); return; }
  if (ph == 1) { p0b(p, lds); return; }
  if (ph == 2) { p0c(p); return; }
  const int l = (ph - 3) / 3, k = (ph - 3) % 3;
  if (k == 0) {
    for (int it = blockIdx.x; it < 96 * 24; it += gridDim.x) { const int nt = it / 96, mt = it % 96; g1_tile(p, l, mt, nt, lds); }
  } else if (k == 1) {
    for (int u = blockIdx.x; u < ATT_UNITS; u += gridDim.x) att_phase_unit(p, l, u, lds);
  } else {
    for (int it = blockIdx.x; it < 96 * 8; it += gridDim.x) { const int nt = it / 96, mt = it % 96; g2_tile(p, l, mt, nt, lds); }
  }
}

__global__ void __launch_bounds__(NTHREADS) fwd_mega(Params p) {
  extern __shared__ __attribute__((aligned(16))) char lds[];
  cg::grid_group grid = cg::this_grid();
  for (int ph = 0; ph < NPHASES; ++ph) {
    run_phase(p, ph, lds);
    if (ph + 1 < NPHASES) grid.sync();
  }
}

__global__ void __launch_bounds__(NTHREADS) fwd_phase(Params p, int ph) {
  extern __shared__ __attribute__((aligned(16))) char lds[];
  run_phase(p, ph, lds);
}

extern "C" void kernel_launch(void* const* d_in, const int* in_sizes, int n_in, void* d_out, int out_size, void* d_ws, size_t ws_size, hipStream_t stream) {
  static int grid_blocks = 0;
  if (!grid_blocks) {
    int dev = 0, cus = 0, per_cu = 0;
    hipGetDevice(&dev);
    hipDeviceGetAttribute(&cus, hipDeviceAttributeMultiprocessorCount, dev);
#if COOP
    hipFuncSetAttribute((const void*)fwd_mega, hipFuncAttributeMaxDynamicSharedMemorySize, LDS_BYTES);
    hipOccupancyMaxActiveBlocksPerMultiprocessor(&per_cu, (const void*)fwd_mega, NTHREADS, LDS_BYTES);
#else
    hipFuncSetAttribute((const void*)fwd_phase, hipFuncAttributeMaxDynamicSharedMemorySize, LDS_BYTES);
    hipOccupancyMaxActiveBlocksPerMultiprocessor(&per_cu, (const void*)fwd_phase, NTHREADS, LDS_BYTES);
#endif
    if (per_cu < 1) per_cu = 1;
    if (per_cu > 2) per_cu = 2;
    grid_blocks = cus * per_cu;
    if (ws_size < WS_END) fprintf(stderr, "workspace too small: %zu < %zu\n", ws_size, (size_t)WS_END);
  }
  Params p{};
  const float** pp = (const float**)&p;
  for (int i = 0; i < 21; ++i) pp[i] = (const float*)d_in[i];
  p.out = (float*)d_out;
  p.ws = (char*)d_ws;
#if COOP
  void* args[] = {&p};
  hipError_t e = hipLaunchCooperativeKernel((const void*)fwd_mega, dim3(grid_blocks), dim3(NTHREADS), args, LDS_BYTES, stream);
  if (e != hipSuccess) fprintf(stderr, "cooperative launch failed: %s (grid %d)\n", hipGetErrorString(e), grid_blocks);
#else
  for (int ph = 0; ph < NPHASES; ++ph) hipLaunchKernelGGL(fwd_phase, dim3(grid_blocks), dim3(NTHREADS), LDS_BYTES, stream, p, ph);
#endif
}
```

```cpp
#include <hip/hip_runtime.h>
#include <hip/hip_cooperative_groups.h>
#include <stdint.h>
#include <cstdio>
namespace cg = cooperative_groups;

#ifndef COOP
#define COOP 1
#endif
#ifndef DUPMASK
#define DUPMASK 0
#endif

typedef unsigned short bf16_t;
typedef short bf16x8 __attribute__((ext_vector_type(8)));
typedef float f32x16 __attribute__((ext_vector_type(16)));
typedef uint32_t u32x4 __attribute__((ext_vector_type(4)));
#define DEVI __device__ __forceinline__

constexpr int NTOK = 12288, NCTX = 8192, DM = 1024, N1 = 3072;
constexpr int NTHREADS = 256;
constexpr int LDP = 1088;
constexpr int LDS_BYTES = 73728;
constexpr int LDS_TOTAL = LDS_BYTES + 16;
constexpr float EPS = 1e-6f;
constexpr float LOG2E = 1.4426950408889634f;

constexpr size_t OFF_WTIN  = 0;
constexpr size_t OFF_WTOUT = OFF_WTIN  + 2ull * 3072 * LDP * 2;
constexpr size_t OFF_W12   = OFF_WTOUT + 2ull * 1024 * LDP * 2;
constexpr size_t OFF_T256  = OFF_W12   + 2ull * 256 * 512 * 4;
constexpr size_t OFF_T1024 = OFF_T256  + 256ull * 512 * 2;
constexpr size_t OFF_ROPEA = OFF_T1024 + 1024ull * 2048 * 2;
constexpr size_t OFF_ROPEB = OFF_ROPEA + 2ull * 1024 * 32 * 4;
constexpr size_t OFF_MOD   = OFF_ROPEB + 2ull * 1024 * 16 * 4;
constexpr size_t OFF_SHW   = OFF_MOD   + 2ull * 5 * 3072 * 4;
constexpr size_t OFF_SSQ   = OFF_SHW   + 2ull * 5 * 3072 * 4;
constexpr size_t OFF_HP    = OFF_SSQ   + 12288ull * 16 * 4;
constexpr size_t OFF_QA    = OFF_HP    + 12288ull * LDP * 2;
constexpr size_t OFF_KA    = OFF_QA    + 12288ull * 512 * 2;
constexpr size_t OFF_VTA   = OFF_KA    + 2ull * 14336 * 128 * 2;
constexpr size_t OFF_QB    = OFF_VTA   + 2ull * 14336 * 128 * 2;
constexpr size_t OFF_KB    = OFF_QB    + 12288ull * 256 * 2;
constexpr size_t OFF_VTB   = OFF_KB    + 2ull * 14336 * 256 * 2;
constexpr size_t OFF_G     = OFF_VTB   + 2ull * 14336 * 256 * 2;
constexpr size_t OFF_PQT   = OFF_G     + 12288ull * 1024 * 2;
constexpr size_t OFF_MIX   = OFF_PQT   + 12288ull * 512 * 2;
constexpr size_t OFF_Y1    = OFF_MIX   + 12288ull * LDP * 2;
constexpr size_t OFF_BAR   = OFF_Y1    + 12288ull * 1024 * 4;
constexpr size_t OFF_KMAX  = OFF_BAR   + 16384;
constexpr size_t OFF_KMAXP = OFF_KMAX  + 256;
constexpr size_t OFF_SHWP  = OFF_KMAXP + 16384;
constexpr size_t WS_END    = OFF_SHWP  + 2ull * 16 * 5 * 512 * 4;

constexpr size_t KA_L = 14336ull * 128, KB_L = 14336ull * 256;

struct Params {
  const float *x_prompt, *x_sample, *cache_a, *cache_b, *c, *c_ctx, *norm_g, *w_mod, *b_mod, *w_in,
      *qn_a, *kn_a, *qn_b, *kn_b, *lq1, *lk1, *lq2, *lk2, *subln_g, *w_c, *w_out;
  float* out;
  char* ws;
};

DEVI uint32_t pk_bf16(float lo, float hi) { uint32_t r; asm("v_cvt_pk_bf16_f32 %0, %1, %2" : "=v"(r) : "v"(lo), "v"(hi)); return r; }
DEVI bf16_t f2bf(float f) { return (bf16_t)(pk_bf16(f, 0.f) & 0xffffu); }
DEVI float bf2f(bf16_t b) { return __uint_as_float(((uint32_t)b) << 16); }
DEVI const float* opq(const float* x) { asm volatile("" : "+s"(x)); return x; }
DEVI int tid() { int t = threadIdx.x; asm volatile("" : "+v"(t)); return t; }
DEVI float silu(float v) { return v * __builtin_amdgcn_rcpf(1.f + __expf(-v)); }
DEVI f32x16 mfma32(bf16x8 a, bf16x8 b, f32x16 c) { return __builtin_amdgcn_mfma_f32_32x32x16_bf16(a, b, c, 0, 0, 0); }
DEVI void st_bf4(bf16_t* p, float a, float b, float c, float d) { uint2 u; u.x = pk_bf16(a, b); u.y = pk_bf16(c, d); *(uint2*)p = u; }


#define XB_TMO      128
#define XB_XCNT(j)  (256  + 64 * (j))
#define XB_XSUB(j)  (1280 + 64 * (j))
#define XB_XGEN(j)  (2304 + 64 * (j))
#define XB_TOP      3328
#define XB_TOPGEN   3392
#define XCD_BAR_WORDS 3456
#define XB_SPIN_CAP (1u << 20)
#define LAS __attribute__((address_space(3)))
DEVI unsigned xb_ld(unsigned* p)              { return __hip_atomic_load(p, __ATOMIC_RELAXED, __HIP_MEMORY_SCOPE_AGENT); }
DEVI unsigned xb_add(unsigned* p, unsigned v) { return __hip_atomic_fetch_add(p, v, __ATOMIC_RELAXED, __HIP_MEMORY_SCOPE_AGENT); }
DEVI unsigned xb_xcc_id() { return (unsigned)__builtin_amdgcn_s_getreg((3 << 11) | 20) & 0xFu; }
#define XB_SPIN(cond, bar) do { unsigned _sp = 0; while (cond) { __builtin_amdgcn_s_sleep(1); \
    if ((++_sp & 255u) == 0u) { if (xb_ld(&(bar)[XB_TMO])) break; if (_sp > XB_SPIN_CAP) { atomicAdd(&(bar)[XB_TMO], 1u); break; } } } } while (0)
struct XcdBarrier { unsigned* bar; unsigned x; volatile LAS unsigned* st; };
DEVI XcdBarrier xcd_barrier_post(unsigned* bar, volatile LAS unsigned* st) {
  XcdBarrier b; b.bar = bar; b.x = xb_xcc_id(); b.st = st;
  if (threadIdx.x == 0) (void)xb_add(&bar[XB_XCNT(b.x)], 1u);
  return b;
}
DEVI void xcd_barrier_complete(unsigned* bar, unsigned x, unsigned& nloc, unsigned& nx) {
  const unsigned G = gridDim.x * gridDim.y * gridDim.z;
  unsigned sum, cnt, mine, sp = 0u;
  for (;;) {
    sum = 0u; cnt = 0u; mine = 0u;
#pragma unroll
    for (unsigned j = 0; j < 16; ++j) { const unsigned c = xb_ld(&bar[XB_XCNT(j)]); sum += c; cnt += (c > 0u) ? 1u : 0u; mine = (j == x) ? c : mine; }
    if (sum == G) break;
    __builtin_amdgcn_s_sleep(1);
    if ((++sp & 255u) == 0u) { if (xb_ld(&bar[XB_TMO])) break; if (sp > XB_SPIN_CAP) { atomicAdd(&bar[XB_TMO], 1u); break; } }
  }
  nloc = mine > 0u ? mine : 1u; nx = cnt > 0u ? cnt : 1u;
}
DEVI void xcd_barrier(const XcdBarrier& b) {
  asm volatile("s_waitcnt vmcnt(0)" ::: "memory");
  __syncthreads();
  if (threadIdx.x == 0) {
    unsigned* bar = b.bar;
    __builtin_amdgcn_s_waitcnt(0);
    unsigned nloc = b.st[0], nx = b.st[1];
    if (nloc == 0u) { xcd_barrier_complete(bar, b.x, nloc, nx); b.st[0] = nloc; b.st[1] = nx; }
    const unsigned old = xb_add(&bar[XB_XSUB(b.x)], 1u);
    const unsigned gen = old / nloc;
    if (old + 1u == (gen + 1u) * nloc) {
      __builtin_amdgcn_fence(__ATOMIC_RELEASE, "agent");
      asm volatile("s_waitcnt vmcnt(0)" ::: "memory");
      const unsigned og = xb_add(&bar[XB_TOP], 1u);
      const unsigned tg = og / nx;
      if (og + 1u == (tg + 1u) * nx) xb_add(&bar[XB_TOPGEN], 1u);
      else XB_SPIN(xb_ld(&bar[XB_TOPGEN]) == tg, bar);
      __builtin_amdgcn_fence(__ATOMIC_ACQUIRE, "agent");
      xb_add(&bar[XB_XGEN(b.x)], 1u);
      asm volatile("s_waitcnt vmcnt(0)" ::: "memory");
    } else {
      XB_SPIN(xb_ld(&bar[XB_XGEN(b.x)]) == gen, bar);
      __builtin_amdgcn_fence(__ATOMIC_ACQUIRE, "agent");
      asm volatile("s_waitcnt vmcnt(0)" ::: "memory");
    }
  }
  __syncthreads();
}

template <int TN = 2>
DEVI void gemm_core(const bf16_t* __restrict__ Ag, int lda, const bf16_t* __restrict__ Bg, int ldb, int K,
                    f32x16 (&acc)[TN][2], char* lds) {
  const int t = tid(), lane = t & 63, wave = t >> 6, wm = wave >> 1, wn = wave & 1;
  const int lr = lane & 31, h = lane >> 5;
#pragma unroll
  for (int a = 0; a < TN; ++a)
#pragma unroll
    for (int b = 0; b < 2; ++b)
#pragma unroll
      for (int i = 0; i < 16; ++i) acc[a][b][i] = 0.f;
  const int nk = K >> 6;
  const int r8 = lane >> 3, cp = lane & 7;
  const bf16_t* as_[4];
  const bf16_t* bs_[2 * TN];
#pragma unroll
  for (int i = 0; i < 4; ++i) { const int r = (wave * 4 + i) * 8 + r8; as_[i] = Ag + (size_t)r * lda + ((cp ^ ((r >> 1) & 7)) << 3); }
#pragma unroll
  for (int i = 0; i < 2 * TN; ++i) { const int r = (wave * 2 * TN + i) * 8 + r8; bs_[i] = Bg + (size_t)r * ldb + ((cp ^ ((r >> 1) & 7)) << 3); }
  LAS char* const l3a = (LAS char*)lds + wave * 4096;
  LAS char* const l3b = (LAS char*)lds + 16384 + wave * (2048 * TN);
#define GLDS(SRC, DST) __builtin_amdgcn_global_load_lds((const unsigned*)(SRC), (LAS unsigned*)(DST), 16, 0, 0)
#define DMA(BUF, KO) { \
    _Pragma("unroll") for (int i_ = 0; i_ < 4; ++i_) GLDS(as_[i_] + (KO), l3a + (BUF) * 32768 + i_ * 1024); \
    _Pragma("unroll") for (int i_ = 0; i_ < 2 * TN; ++i_) GLDS(bs_[i_] + (KO), l3b + (BUF) * 32768 + i_ * 1024); }
  const int swz = (lr >> 1) & 7;
  const int offA = (wm * 64 + lr) * 128, offB = 16384 + (wn * 32 * TN + lr) * 128;
#define COMPUTE(SA) { const char* s_ = (SA); \
    _Pragma("unroll") for (int ks = 0; ks < 4; ++ks) { bf16x8 fa[TN], fb[2]; const int co = ((ks * 2 + h) ^ swz) << 4; \
      _Pragma("unroll") for (int j = 0; j < 2; ++j) fb[j] = *(const bf16x8*)(s_ + offA + j * 4096 + co); \
      _Pragma("unroll") for (int j = 0; j < TN; ++j) fa[j] = *(const bf16x8*)(s_ + offB + j * 4096 + co); \
      _Pragma("unroll") for (int tn = 0; tn < TN; ++tn) _Pragma("unroll") for (int tm = 0; tm < 2; ++tm) acc[tn][tm] = mfma32(fa[tn], fb[tm], acc[tn][tm]); } }
  DMA(0, 0);
  asm volatile("s_waitcnt vmcnt(0)" ::: "memory");
  __syncthreads();
  for (int kt = 0; kt < nk; ++kt) {
    if (kt + 1 < nk) DMA((kt + 1) & 1, (kt + 1) * 64);
    COMPUTE(lds + (kt & 1) * 32768);
    asm volatile("s_waitcnt vmcnt(0)" ::: "memory");
    __syncthreads();
  }
#undef GLDS
#undef DMA
#undef COMPUTE
}

DEVI void g1_tile(const Params& p, int l, int mt, int nt, char* lds) {
  const int m0 = mt * 128, n0 = nt * 128;
  const bf16_t* HP = (const bf16_t*)(p.ws + OFF_HP);
  const bf16_t* WT = (const bf16_t*)(p.ws + OFF_WTIN) + (size_t)l * 3072 * LDP;
  const int t = tid(), lane = t & 63, wave = t >> 6, wm = wave >> 1, wn = wave & 1, lr = lane & 31, h = lane >> 5;
  const int nb = n0 + wn * 64;
  const bool lat = m0 >= NCTX;
  const int jb = lat ? ((m0 - NCTX) >> 10) : 0;
  const int cond = lat ? 1 + jb : 0;
  int type;
  if (n0 < 512) type = 0; else if (n0 < 640) type = 1; else if (n0 < 768) type = 2;
  else if (n0 < 1280) type = 3;
  else if (n0 < 1536) type = 4; else if (n0 < 1792) type = 5; else if (n0 < 2048) type = 6;
  else if (n0 < 2304) type = 3;
  else if (n0 < 2816) type = 7;
  else type = 3;
  float* X = (float*)(lds + 65536);
  if (t < 128) {
    const float4* sp = (const float4*)((const float*)(p.ws + OFF_SSQ) + (size_t)(m0 + t) * 16);
    const float4 a = sp[0], b = sp[1], c4 = sp[2], d = sp[3];
    const float ss = ((a.x + a.y) + (a.z + a.w)) + ((b.x + b.y) + (b.z + b.w)) + ((c4.x + c4.y) + (c4.z + c4.w)) + ((d.x + d.y) + (d.z + d.w));
    X[t] = rsqrtf(ss * (1.f / 1024.f) + EPS);
  } else {
    const int col = t - 128;
    float shv;
    if (type == 7) {
      const float* sp = (const float*)(p.ws + OFF_SHWP) + ((size_t)(l * 16) * 5 + cond) * 512 + (n0 - 2304) + col;
      shv = 0.f;
#pragma unroll
      for (int g = 0; g < 16; ++g) shv += sp[(size_t)g * 5 * 512];
    } else shv = ((const float*)(p.ws + OFF_SHW))[(size_t)(l * 5 + cond) * 3072 + n0 + col];
    X[128 + col] = shv;
    float g = 1.f;
    if (type == 0) g = p.qn_a[l * 64 + (col & 63)];
    else if (type == 1) g = p.kn_a[l * 64 + (col & 63)];
    else if (type == 4) g = p.qn_b[l * 32 + (col & 31)];
    else if (type == 5) g = p.kn_b[l * 32 + (col & 31)];
    X[256 + col] = g;
  }
  f32x16 acc[2][2];
  gemm_core<2>(HP + (size_t)m0 * LDP, LDP, WT + (size_t)n0 * LDP, LDP, 1024, acc, lds);

  float sw[2][16];
#pragma unroll
  for (int tn = 0; tn < 2; ++tn)
#pragma unroll
    for (int q = 0; q < 4; ++q) { const float4 s4 = *(const float4*)(X + 128 + wn * 64 + tn * 32 + q * 8 + h * 4); sw[tn][q * 4 + 0] = s4.x; sw[tn][q * 4 + 1] = s4.y; sw[tn][q * 4 + 2] = s4.z; sw[tn][q * 4 + 3] = s4.w; }

  bf16_t* E = (bf16_t*)lds;
  const float* ropeA = (const float*)(p.ws + OFF_ROPEA);
  const float* ropeB = (const float*)(p.ws + OFF_ROPEB);

#pragma unroll
  for (int tm = 0; tm < 2; ++tm) {
    const int trow = wm * 64 + tm * 32 + lr;
    const int tok = m0 + trow;
    const float rstd = X[trow];
    float v[2][16];
#pragma unroll
    for (int tn = 0; tn < 2; ++tn)
#pragma unroll
      for (int i = 0; i < 16; ++i) v[tn][i] = rstd * acc[tn][tm][i] + sw[tn][i];

    int s, bq, Lk, krow; size_t vbA, vbB, pqb; int S;
    if (!lat) { bq = tok >> 8; s = tok & 255; Lk = 256; krow = tok; vbA = (size_t)bq * 32768; vbB = (size_t)bq * 65536; pqb = (size_t)bq * 131072; S = 256; }
    else { bq = jb; s = (tok - NCTX) & 1023; Lk = 1536; krow = NCTX + jb * 1536 + s; vbA = 1048576 + (size_t)jb * 196608; vbB = 2097152 + (size_t)jb * 393216; pqb = 32ull * 131072 + (size_t)jb * 524288; S = 1024; }

    if (type == 3) {
      bf16_t* G = E + trow * 136 + wn * 64 + h * 4;
#pragma unroll
      for (int tn = 0; tn < 2; ++tn)
#pragma unroll
        for (int q = 0; q < 4; ++q) st_bf4(G + tn * 32 + q * 8, silu(v[tn][q * 4]), silu(v[tn][q * 4 + 1]), silu(v[tn][q * 4 + 2]), silu(v[tn][q * 4 + 3]));
    } else if (type == 0 || type == 1) {
      float ss = 0.f;
#pragma unroll
      for (int tn = 0; tn < 2; ++tn)
#pragma unroll
        for (int i = 0; i < 16; ++i) ss += v[tn][i] * v[tn][i];
      ss += __shfl_xor(ss, 32);
      const float r = rsqrtf(ss * (1.f / 64.f) + EPS);
      const float* gp = X + 256 + wn * 64 + h * 4;
#pragma unroll
      for (int tn = 0; tn < 2; ++tn)
#pragma unroll
        for (int q = 0; q < 4; ++q) { const float4 g4 = *(const float4*)(gp + tn * 32 + q * 8); v[tn][q * 4] *= r * g4.x; v[tn][q * 4 + 1] *= r * g4.y; v[tn][q * 4 + 2] *= r * g4.z; v[tn][q * 4 + 3] *= r * g4.w; }
      if (type == 1 && !lat) {
        const int kvh = wn;
        float* o = p.out + 12582912ull + ((((size_t)(bq * 2 + l) * 256 + s) * 2 + 0) * 2 + kvh) * 64 + h * 4;
#pragma unroll
        for (int tn = 0; tn < 2; ++tn)
#pragma unroll
          for (int q = 0; q < 4; ++q) *(float4*)(o + tn * 32 + q * 8) = make_float4(v[tn][q * 4], v[tn][q * 4 + 1], v[tn][q * 4 + 2], v[tn][q * 4 + 3]);
      }
      if (lat) {
        const float* cp = ropeA + (size_t)s * 32 + h * 4;
        const float* sp = cp + 1024 * 32;
#pragma unroll
        for (int tn = 0; tn < 2; ++tn)
#pragma unroll
          for (int q = 0; q < 2; ++q) {
            const float4 c4 = *(const float4*)(cp + tn * 16 + q * 8), s4 = *(const float4*)(sp + tn * 16 + q * 8);
            const float cc[4] = {c4.x, c4.y, c4.z, c4.w}, sn[4] = {s4.x, s4.y, s4.z, s4.w};
#pragma unroll
            for (int e = 0; e < 4; ++e) { const float x1 = v[tn][q * 4 + e], x2 = v[tn][(q + 2) * 4 + e]; v[tn][q * 4 + e] = x1 * cc[e] - x2 * sn[e]; v[tn][(q + 2) * 4 + e] = x1 * sn[e] + x2 * cc[e]; }
          }
      }
      if (type == 0) {
        const float sc = 0.125f * LOG2E;
        bf16_t* Q = E + trow * 136 + wn * 64 + h * 4;
#pragma unroll
        for (int tn = 0; tn < 2; ++tn)
#pragma unroll
          for (int q = 0; q < 4; ++q) st_bf4(Q + tn * 32 + q * 8, v[tn][q * 4] * sc, v[tn][q * 4 + 1] * sc, v[tn][q * 4 + 2] * sc, v[tn][q * 4 + 3] * sc);
      } else {
        bf16_t* Kp = E + trow * 136 + wn * 64 + h * 4;
#pragma unroll
        for (int tn = 0; tn < 2; ++tn)
#pragma unroll
          for (int q = 0; q < 4; ++q) st_bf4(Kp + tn * 32 + q * 8, v[tn][q * 4], v[tn][q * 4 + 1], v[tn][q * 4 + 2], v[tn][q * 4 + 3]);
      }
    } else if (type == 2) {
      const int kvh = wn;
      if (!lat) {
        float* o = p.out + 12582912ull + ((((size_t)(bq * 2 + l) * 256 + s) * 2 + 1) * 2 + kvh) * 64 + h * 4;
#pragma unroll
        for (int tn = 0; tn < 2; ++tn)
#pragma unroll
          for (int q = 0; q < 4; ++q) *(float4*)(o + tn * 32 + q * 8) = make_float4(v[tn][q * 4], v[tn][q * 4 + 1], v[tn][q * 4 + 2], v[tn][q * 4 + 3]);
      }
      bf16_t* Vt = E + (wn * 64 + h * 4) * 136 + trow;
#pragma unroll
      for (int tn = 0; tn < 2; ++tn)
#pragma unroll
        for (int i = 0; i < 16; ++i) Vt[(tn * 32 + (i >> 2) * 8 + (i & 3)) * 136] = f2bf(v[tn][i]);
    } else if (type == 4 || type == 5) {
      const int hb = (nb - (type == 4 ? 1280 : 1536)) >> 6;
      const float* gp = X + 256 + wn * 64 + h * 4;
#pragma unroll
      for (int tn = 0; tn < 2; ++tn) {
        float ss = 0.f;
#pragma unroll
        for (int i = 0; i < 16; ++i) ss += v[tn][i] * v[tn][i];
        ss += __shfl_xor(ss, 32);
        const float r = rsqrtf(ss * (1.f / 32.f) + EPS);
#pragma unroll
        for (int q = 0; q < 4; ++q) { const float4 g4 = *(const float4*)(gp + q * 8); v[tn][q * 4] *= r * g4.x; v[tn][q * 4 + 1] *= r * g4.y; v[tn][q * 4 + 2] *= r * g4.z; v[tn][q * 4 + 3] *= r * g4.w; }
      }
      if (type == 5 && !lat) {
        float* o = p.out + 16777216ull + ((((size_t)(bq * 2 + l) * 256 + s) * 2 + 0) * 4 + hb) * 64 + h * 4;
#pragma unroll
        for (int tn = 0; tn < 2; ++tn)
#pragma unroll
          for (int q = 0; q < 4; ++q) *(float4*)(o + tn * 32 + q * 8) = make_float4(v[tn][q * 4], v[tn][q * 4 + 1], v[tn][q * 4 + 2], v[tn][q * 4 + 3]);
      }
      if (lat) {
        const float* cp = ropeB + (size_t)s * 16 + h * 4;
        const float* sp = cp + 1024 * 16;
#pragma unroll
        for (int hf = 0; hf < 2; ++hf) {
          const float4 c4 = *(const float4*)(cp + hf * 8), s4 = *(const float4*)(sp + hf * 8);
          const float cc[4] = {c4.x, c4.y, c4.z, c4.w}, sn[4] = {s4.x, s4.y, s4.z, s4.w};
#pragma unroll
          for (int tn = 0; tn < 2; ++tn)
#pragma unroll
            for (int e = 0; e < 4; ++e) { const float x1 = v[tn][(2 * hf) * 4 + e], x2 = v[tn][(2 * hf + 1) * 4 + e]; v[tn][(2 * hf) * 4 + e] = x1 * cc[e] - x2 * sn[e]; v[tn][(2 * hf + 1) * 4 + e] = x1 * sn[e] + x2 * cc[e]; }
        }
      }
      if (type == 4) {
        const float sc = 0.17677669529663687f * LOG2E;
        bf16_t* Q = E + trow * 136 + wn * 64 + h * 4;
#pragma unroll
        for (int tn = 0; tn < 2; ++tn)
#pragma unroll
          for (int q = 0; q < 4; ++q) st_bf4(Q + tn * 32 + q * 8, v[tn][q * 4] * sc, v[tn][q * 4 + 1] * sc, v[tn][q * 4 + 2] * sc, v[tn][q * 4 + 3] * sc);
      } else {
        bf16_t* Kp = E + trow * 136 + wn * 64 + h * 4;
#pragma unroll
        for (int tn = 0; tn < 2; ++tn)
#pragma unroll
          for (int q = 0; q < 4; ++q) st_bf4(Kp + tn * 32 + q * 8, v[tn][q * 4], v[tn][q * 4 + 1], v[tn][q * 4 + 2], v[tn][q * 4 + 3]);
      }
    } else if (type == 6) {
      const int hb = (nb - 1792) >> 6;
      if (!lat) {
        float* o = p.out + 16777216ull + ((((size_t)(bq * 2 + l) * 256 + s) * 2 + 1) * 4 + hb) * 64 + h * 4;
#pragma unroll
        for (int tn = 0; tn < 2; ++tn)
#pragma unroll
          for (int q = 0; q < 4; ++q) *(float4*)(o + tn * 32 + q * 8) = make_float4(v[tn][q * 4], v[tn][q * 4 + 1], v[tn][q * 4 + 2], v[tn][q * 4 + 3]);
      }
      bf16_t* Vt = E + (wn * 64 + h * 4) * 136 + trow;
#pragma unroll
      for (int tn = 0; tn < 2; ++tn)
#pragma unroll
        for (int i = 0; i < 16; ++i) Vt[(tn * 32 + (i >> 2) * 8 + (i & 3)) * 136] = f2bf(v[tn][i]);
    } else {
      bf16_t* PQ = E + (wn * 64 + h * 4) * 136 + trow;
#pragma unroll
      for (int tn = 0; tn < 2; ++tn)
#pragma unroll
        for (int i = 0; i < 16; ++i) PQ[(tn * 32 + (i >> 2) * 8 + (i & 3)) * 136] = f2bf(v[tn][i]);
    }
  }
  __syncthreads();
  {
    const int s0 = lat ? ((m0 - NCTX) & 1023) : (m0 & 255);
    const int krow0 = lat ? NCTX + jb * 1536 + s0 : m0;
    const int Lk0 = lat ? 1536 : 256, S0 = lat ? 1024 : 256;
    const int bq0 = lat ? jb : (m0 >> 8);
    bf16_t* dst; size_t stride;
    if (type == 0) { dst = (bf16_t*)(p.ws + OFF_QA) + (size_t)m0 * 512 + n0; stride = 512; }
    else if (type == 1) { dst = (bf16_t*)(p.ws + OFF_KA) + (size_t)l * KA_L + (size_t)krow0 * 128; stride = 128; }
    else if (type == 2) { dst = (bf16_t*)(p.ws + OFF_VTA) + (size_t)l * KA_L + (lat ? 1048576 + (size_t)jb * 196608 : (size_t)bq0 * 32768) + s0; stride = Lk0; }
    else if (type == 3) { const int g0 = n0 < 1280 ? n0 - 768 : (n0 < 2304 ? 512 + n0 - 2048 : 768 + n0 - 2816); dst = (bf16_t*)(p.ws + OFF_G) + (size_t)m0 * 1024 + g0; stride = 1024; }
    else if (type == 4) { dst = (bf16_t*)(p.ws + OFF_QB) + (size_t)m0 * 256 + (n0 - 1280); stride = 256; }
    else if (type == 5) { dst = (bf16_t*)(p.ws + OFF_KB) + (size_t)l * KB_L + (size_t)krow0 * 256 + (n0 - 1536); stride = 256; }
    else if (type == 6) { dst = (bf16_t*)(p.ws + OFF_VTB) + (size_t)l * KB_L + (lat ? 2097152 + (size_t)jb * 393216 : (size_t)bq0 * 65536) + (size_t)(n0 - 1792) * Lk0 + s0; stride = Lk0; }
    else { const int nn0 = n0 - 2304; dst = (bf16_t*)(p.ws + OFF_PQT) + (lat ? 32ull * 131072 + (size_t)jb * 524288 : (size_t)bq0 * 131072) + (size_t)(nn0 & 255) * (2 * S0) + (nn0 >> 8) * S0 + s0; stride = 2 * S0; }
    const int c = t & 15, r0 = t >> 4;
#pragma unroll
    for (int i = 0; i < 8; ++i) { const int r = r0 + 16 * i; *(uint4*)(dst + (size_t)r * stride + c * 8) = *(const uint4*)(E + r * 136 + c * 8); }
  }
  __syncthreads();
}

DEVI void g2_tile(const Params& p, int l, int mt, int nt, char* lds) {
  const int m0 = mt * 128, n0 = nt * 128;
  const bf16_t* MIX = (const bf16_t*)(p.ws + OFF_MIX);
  const bf16_t* WT = (const bf16_t*)(p.ws + OFF_WTOUT) + (size_t)l * 1024 * LDP;
  f32x16 acc[2][2];
  gemm_core<2>(MIX + (size_t)m0 * LDP, LDP, WT + (size_t)n0 * LDP, LDP, 1024, acc, lds);

  const int t = tid(), lane = t & 63, wave = t >> 6, wm = wave >> 1, wn = wave & 1, lr = lane & 31, h = lane >> 5;
  float* E = (float*)lds;
#pragma unroll
  for (int tm = 0; tm < 2; ++tm)
#pragma unroll
    for (int tn = 0; tn < 2; ++tn)
#pragma unroll
      for (int q = 0; q < 4; ++q)
        *(float4*)(E + (wm * 64 + tm * 32 + lr) * 132 + wn * 64 + tn * 32 + q * 8 + h * 4) =
            make_float4(acc[tn][tm][q * 4], acc[tn][tm][q * 4 + 1], acc[tn][tm][q * 4 + 2], acc[tn][tm][q * 4 + 3]);
  __syncthreads();
  const bool lat = m0 >= NCTX;
  const int cond = lat ? 1 + ((m0 - NCTX) >> 10) : 0;
  const float* MOD = (const float*)(p.ws + OFF_MOD);
  const int c4 = (t & 31) * 4, rb = t >> 5;
  const float4 g4 = *(const float4*)(MOD + (size_t)(l * 5 + cond) * 3072 + 2048 + n0 + c4);
  float4 gs = make_float4(0.f, 0.f, 0.f, 0.f);
  if (l == 0) {
    const float4 ng = *(const float4*)(p.norm_g + 1024 + n0 + c4);
    const float4 sc = *(const float4*)(MOD + (size_t)(5 + cond) * 3072 + 1024 + n0 + c4);
    gs = make_float4(ng.x * (1.f + sc.x), ng.y * (1.f + sc.y), ng.z * (1.f + sc.z), ng.w * (1.f + sc.w));
  }
  const float* xa = opq(p.x_prompt); const float* xb = opq(p.x_sample);
  const float* xin = (lat ? xb + (size_t)(m0 - NCTX) * 1024 : xa + (size_t)m0 * 1024) + n0 + c4;
  bf16_t* y1p = (bf16_t*)(p.ws + OFF_Y1) + (size_t)m0 * 1024 + n0 + c4;
  float* yout = p.out + (size_t)m0 * 1024 + n0 + c4;
  float4 xv[16];
  if (l == 0) {
#pragma unroll
    for (int i = 0; i < 16; ++i) xv[i] = *(const float4*)(xin + (size_t)(rb + 8 * i) * 1024);
  } else {
    uint2 xu[16];
#pragma unroll
    for (int i = 0; i < 16; ++i) xu[i] = *(const uint2*)(y1p + (size_t)(rb + 8 * i) * 1024);
#pragma unroll
    for (int i = 0; i < 16; ++i) xv[i] = make_float4(__uint_as_float(xu[i].x << 16), __uint_as_float(xu[i].x & 0xffff0000u), __uint_as_float(xu[i].y << 16), __uint_as_float(xu[i].y & 0xffff0000u));
  }
#pragma unroll
  for (int i = 0; i < 16; ++i) {
    const int r = rb + 8 * i;
    const float4 a4 = *(const float4*)(E + r * 132 + c4);
    float4 y;
    y.x = xv[i].x + g4.x * a4.x; y.y = xv[i].y + g4.y * a4.y; y.z = xv[i].z + g4.z * a4.z; y.w = xv[i].w + g4.w * a4.w;
    if (l != 0) *(float4*)(yout + (size_t)r * 1024) = y;
    if (l == 0) {
      st_bf4(y1p + (size_t)r * 1024, y.x, y.y, y.z, y.w);
      st_bf4((bf16_t*)(p.ws + OFF_HP) + (size_t)(m0 + r) * LDP + n0 + c4, y.x * gs.x, y.y * gs.y, y.z * gs.z, y.w * gs.w);
      float ss = y.x * y.x + y.y * y.y + y.z * y.z + y.w * y.w;
#pragma unroll
      for (int o = 16; o > 0; o >>= 1) ss += __shfl_xor(ss, o);
      if ((t & 31) == 0) *(float2*)((float*)(p.ws + OFF_SSQ) + (size_t)(m0 + r) * 16 + nt * 2) = make_float2(ss, 0.f);
    }
  }
  __syncthreads();
}

DEVI void g2_half_tile(const Params& p, int l, int mt, int nth, char* lds) {
  const int m0 = mt * 128, n0 = nth * 64;
  const bf16_t* MIX = (const bf16_t*)(p.ws + OFF_MIX);
  const bf16_t* WT = (const bf16_t*)(p.ws + OFF_WTOUT) + (size_t)l * 1024 * LDP;
  f32x16 acc[1][2];
  gemm_core<1>(MIX + (size_t)m0 * LDP, LDP, WT + (size_t)n0 * LDP, LDP, 1024, acc, lds);

  const int t = tid(), lane = t & 63, wave = t >> 6, wm = wave >> 1, wn = wave & 1, lr = lane & 31, h = lane >> 5;
  float* E = (float*)lds;
#pragma unroll
  for (int tm = 0; tm < 2; ++tm)
#pragma unroll
    for (int q = 0; q < 4; ++q)
      *(float4*)(E + (wm * 64 + tm * 32 + lr) * 68 + wn * 32 + q * 8 + h * 4) =
          make_float4(acc[0][tm][q * 4], acc[0][tm][q * 4 + 1], acc[0][tm][q * 4 + 2], acc[0][tm][q * 4 + 3]);
  __syncthreads();
  const bool lat = m0 >= NCTX;
  const int cond = lat ? 1 + ((m0 - NCTX) >> 10) : 0;
  const float* MOD = (const float*)(p.ws + OFF_MOD);
  const int c4 = (t & 15) * 4, rb = t >> 4;
  const float4 g4 = *(const float4*)(MOD + (size_t)(l * 5 + cond) * 3072 + 2048 + n0 + c4);
  float4 gs = make_float4(0.f, 0.f, 0.f, 0.f);
  if (l == 0) {
    const float4 ng = *(const float4*)(p.norm_g + 1024 + n0 + c4);
    const float4 sc = *(const float4*)(MOD + (size_t)(5 + cond) * 3072 + 1024 + n0 + c4);
    gs = make_float4(ng.x * (1.f + sc.x), ng.y * (1.f + sc.y), ng.z * (1.f + sc.z), ng.w * (1.f + sc.w));
  }
  const float* xa = opq(p.x_prompt); const float* xb = opq(p.x_sample);
  const float* xin = (lat ? xb + (size_t)(m0 - NCTX) * 1024 : xa + (size_t)m0 * 1024) + n0 + c4;
  bf16_t* y1p = (bf16_t*)(p.ws + OFF_Y1) + (size_t)m0 * 1024 + n0 + c4;
  float* yout = p.out + (size_t)m0 * 1024 + n0 + c4;
  float4 xv[8];
  if (l == 0) {
#pragma unroll
    for (int i = 0; i < 8; ++i) xv[i] = *(const float4*)(xin + (size_t)(rb + 16 * i) * 1024);
  } else {
    uint2 xu[8];
#pragma unroll
    for (int i = 0; i < 8; ++i) xu[i] = *(const uint2*)(y1p + (size_t)(rb + 16 * i) * 1024);
#pragma unroll
    for (int i = 0; i < 8; ++i) xv[i] = make_float4(__uint_as_float(xu[i].x << 16), __uint_as_float(xu[i].x & 0xffff0000u), __uint_as_float(xu[i].y << 16), __uint_as_float(xu[i].y & 0xffff0000u));
  }
#pragma unroll
  for (int i = 0; i < 8; ++i) {
    const int r = rb + 16 * i;
    const float4 a4 = *(const float4*)(E + r * 68 + c4);
    float4 y;
    y.x = xv[i].x + g4.x * a4.x; y.y = xv[i].y + g4.y * a4.y; y.z = xv[i].z + g4.z * a4.z; y.w = xv[i].w + g4.w * a4.w;
    if (l != 0) *(float4*)(yout + (size_t)r * 1024) = y;
    if (l == 0) {
      st_bf4(y1p + (size_t)r * 1024, y.x, y.y, y.z, y.w);
      st_bf4((bf16_t*)(p.ws + OFF_HP) + (size_t)(m0 + r) * LDP + n0 + c4, y.x * gs.x, y.y * gs.y, y.z * gs.z, y.w * gs.w);
      float ss = y.x * y.x + y.y * y.y + y.z * y.z + y.w * y.w;
#pragma unroll
      for (int o = 8; o > 0; o >>= 1) ss += __shfl_xor(ss, o);
      if ((t & 15) == 0) ((float*)(p.ws + OFF_SSQ))[(size_t)(m0 + r) * 16 + nth] = ss;
    }
  }
  __syncthreads();
}

DEVI void attn_rows_out(const Params& p, const float* Ot, int tokbase, int colbase, const float* gain, int lane);
DEVI void fourier_tile(const Params& p, int tok_seq0, int S, size_t pqb, int mt, int nt, char* lds) {
  const bf16_t* T = (const bf16_t*)(p.ws + (S == 256 ? OFF_T256 : OFF_T1024));
  const bf16_t* PQ = (const bf16_t*)(p.ws + OFF_PQT) + pqb;
  f32x16 acc[2][2];
  gemm_core<2>(T + (size_t)(mt * 128) * (2 * S), 2 * S, PQ + (size_t)(nt * 128) * (2 * S), 2 * S, 2 * S, acc, lds);
  const int t = tid(), lane = t & 63, wave = t >> 6, wm = wave >> 1, wn = wave & 1, lr = lane & 31, h = lane >> 5;
  float* Ot = (float*)lds + wave * (64 * 68);
#pragma unroll
  for (int tm = 0; tm < 2; ++tm)
#pragma unroll
    for (int tn = 0; tn < 2; ++tn)
#pragma unroll
      for (int q = 0; q < 4; ++q)
        *(float4*)(Ot + (tm * 32 + lr) * 68 + tn * 32 + q * 8 + h * 4) = make_float4(acc[tn][tm][q * 4], acc[tn][tm][q * 4 + 1], acc[tn][tm][q * 4 + 2], acc[tn][tm][q * 4 + 3]);
  const int tokb = tok_seq0 + mt * 128 + wm * 64, colb = 768 + nt * 128 + wn * 64;
  attn_rows_out(p, Ot, tokb, colb, nullptr, lane);
  attn_rows_out(p, Ot + 32 * 68, tokb + 32, colb, nullptr, lane);
}

DEVI void attn_rows_out(const Params& p, const float* Ot, int tokbase, int colbase, const float* gain, int lane) {
  const int rr = lane >> 3, ch = lane & 7;
  const bf16_t* Gb = (const bf16_t*)(p.ws + OFF_G) + (size_t)tokbase * 1024 + colbase + ch * 8;
  bf16_t* Mb = (bf16_t*)(p.ws + OFF_MIX) + (size_t)tokbase * LDP + colbase + ch * 8;
  uint4 g8[4];
#pragma unroll
  for (int i = 0; i < 4; ++i) g8[i] = *(const uint4*)(Gb + (size_t)(rr + 8 * i) * 1024);
  float4 s0 = make_float4(1.f, 1.f, 1.f, 1.f), s1 = s0;
  if (gain) { s0 = *(const float4*)(gain + ch * 8); s1 = *(const float4*)(gain + ch * 8 + 4); }
#pragma unroll
  for (int i = 0; i < 4; ++i) {
    const int row = rr + 8 * i;
    const float4 a = *(const float4*)(Ot + row * 68 + ch * 8), b = *(const float4*)(Ot + row * 68 + ch * 8 + 4);
    const uint4 g = g8[i];
    uint4 o;
    o.x = pk_bf16(a.x * s0.x * __uint_as_float(g.x << 16), a.y * s0.y * __uint_as_float(g.x & 0xffff0000u));
    o.y = pk_bf16(a.z * s0.z * __uint_as_float(g.y << 16), a.w * s0.w * __uint_as_float(g.y & 0xffff0000u));
    o.z = pk_bf16(b.x * s1.x * __uint_as_float(g.z << 16), b.y * s1.y * __uint_as_float(g.z & 0xffff0000u));
    o.w = pk_bf16(b.z * s1.z * __uint_as_float(g.w << 16), b.w * s1.w * __uint_as_float(g.w & 0xffff0000u));
    *(uint4*)(Mb + (size_t)row * LDP) = o;
  }
}

template <int NC>
DEVI void attn_unit(const Params& p, int l, int tok0, int head, char* lds) {
  const int t = tid(), lane = t & 63, wave = t >> 6, lr = lane & 31, h = lane >> 5;
  constexpr int KS = 4 / NC;
  const int comp = (NC == 1) ? 0 : (wave >> 1);
  const int qrow = (NC == 1) ? wave * 32 : (wave & 1) * 32;
  const bool lat = tok0 >= NCTX;
  int Lk, krow0; size_t vbase;
  if (!lat) { const int b = tok0 >> 8; Lk = 256; krow0 = b * 256; vbase = (NC == 1) ? (size_t)b * 32768 : (size_t)b * 65536; }
  else { const int j = (tok0 - NCTX) >> 10; Lk = 1536; krow0 = NCTX + j * 1536; vbase = (NC == 1) ? 1048576 + (size_t)j * 196608 : 2097152 + (size_t)j * 393216; }
  const bf16_t *Kg, *Vg, *Qg; int kst, qst;
  if (NC == 1) {
    const int kvh = head >> 2;
    Kg = (const bf16_t*)(p.ws + OFF_KA) + (size_t)l * KA_L + (size_t)krow0 * 128 + kvh * 64; kst = 128;
    Vg = (const bf16_t*)(p.ws + OFF_VTA) + (size_t)l * KA_L + vbase + (size_t)kvh * 64 * Lk;
    Qg = (const bf16_t*)(p.ws + OFF_QA) + (size_t)tok0 * 512 + head * 64; qst = 512;
  } else {
    Kg = (const bf16_t*)(p.ws + OFF_KB) + (size_t)l * KB_L + (size_t)krow0 * 256 + head * 64; kst = 256;
    Vg = (const bf16_t*)(p.ws + OFF_VTB) + (size_t)l * KB_L + vbase + (size_t)head * 64 * Lk;
    Qg = (const bf16_t*)(p.ws + OFF_QB) + (size_t)tok0 * 256 + head * 64; qst = 256;
  }
  bf16x8 qf[KS];
  {
    const bf16_t* qp = Qg + (size_t)(qrow + lr) * qst + comp * 32 + h * 8;
#pragma unroll
    for (int j = 0; j < KS; ++j) qf[j] = *(const bf16x8*)(qp + j * 16);
  }
  float Mb;
  {
    constexpr int DQ = 64 / NC;
    const float* gqp = (NC == 1) ? p.qn_a : p.qn_b;
    const float* gkp = (NC == 1) ? p.kn_a : p.kn_b;
    float gq = fabsf(gqp[l * DQ + (lane & (DQ - 1))]), gk = fabsf(gkp[l * DQ + (lane & (DQ - 1))]);
#pragma unroll
    for (int o = 32; o > 0; o >>= 1) { gq = fmaxf(gq, __shfl_xor(gq, o)); gk = fmaxf(gk, __shfl_xor(gk, o)); }
    const float qn = sqrtf((float)DQ) * gq;
    float kn = sqrtf((float)DQ) * gk;
    if (lat) kn = fmaxf(kn, sqrtf(((const float*)(p.ws + OFF_KMAX))[l * 2 + NC - 1]));
    Mb = qn * kn * ((NC == 1) ? 0.125f : 0.17677669529663687f) * LOG2E * 1.02f;
  }
  const bool fast = Mb < 56.f;
  f32x16 O[2];
  float mrun = -INFINITY, lsum = 0.f;
#pragma unroll
  for (int dt = 0; dt < 2; ++dt)
#pragma unroll
    for (int i = 0; i < 16; ++i) O[dt][i] = 0.f;
  const int c8 = t & 7, r0 = t >> 3;
  uint4 rk0, rk1, rv0, rv1;
  uint4 sk0, sk1, sv0, sv1;
  const bf16_t* kp = Kg + (size_t)r0 * kst + c8 * 8;
  const bf16_t* vp = Vg + (size_t)r0 * Lk + c8 * 8;
  const int nkt = Lk >> 6;
#define ALOAD0(KT) { rk0 = *(const uint4*)(kp + (size_t)((KT) * 64) * kst); rk1 = *(const uint4*)(kp + (size_t)((KT) * 64 + 32) * kst); \
                     rv0 = *(const uint4*)(vp + (KT) * 64); rv1 = *(const uint4*)(vp + (size_t)32 * Lk + (KT) * 64); }
#define ALOAD1(KT) { sk0 = *(const uint4*)(kp + (size_t)((KT) * 64) * kst); sk1 = *(const uint4*)(kp + (size_t)((KT) * 64 + 32) * kst); \
                     sv0 = *(const uint4*)(vp + (KT) * 64); sv1 = *(const uint4*)(vp + (size_t)32 * Lk + (KT) * 64); }
#define AWRITE0(W) { *(uint4*)(W) = rk0; *(uint4*)((W) + 32 * 144) = rk1; *(uint4*)((W) + 9216) = rv0; *(uint4*)((W) + 9216 + 32 * 144) = rv1; }
#define AWRITE1(W) { *(uint4*)(W) = sk0; *(uint4*)((W) + 32 * 144) = sk1; *(uint4*)((W) + 9216) = sv0; *(uint4*)((W) + 9216 + 32 * 144) = sv1; }
  auto tile = [&](const char* base) {
    const char* sK = base + comp * 64;
    const char* sV = base + 9216;
#pragma unroll
    for (int kk = 0; kk < 2; ++kk) {
      asm volatile("" ::: "memory");
      bf16x8 pf[2];
      f32x16 S;
      const float sinit = fast ? -Mb : 0.f;
#pragma unroll
      for (int i = 0; i < 16; ++i) S[i] = sinit;
#pragma unroll
      for (int j = 0; j < KS; ++j) {
        const bf16x8 kf = *(const bf16x8*)(sK + ((kk * 32 + lr) * 72 + j * 16 + h * 8) * 2);
        S = mfma32(kf, qf[j], S);
      }
      if (fast) {
        float ps = 0.f;
#pragma unroll
        for (int i = 0; i < 16; ++i) { S[i] = __builtin_amdgcn_exp2f(S[i]); ps += S[i]; }
        lsum += ps;
      } else {
        float mx = S[0];
#pragma unroll
        for (int i = 1; i < 16; ++i) mx = fmaxf(mx, S[i]);
        mx = fmaxf(mx, __shfl_xor(mx, 32));
        const float mnew = fmaxf(mrun, mx);
        const float alpha = __builtin_amdgcn_exp2f(mrun - mnew);
        mrun = mnew;
        float ps = 0.f;
#pragma unroll
        for (int i = 0; i < 16; ++i) { S[i] = __builtin_amdgcn_exp2f(S[i] - mnew); ps += S[i]; }
        lsum = lsum * alpha + ps;
#pragma unroll
        for (int dt = 0; dt < 2; ++dt)
#pragma unroll
          for (int i = 0; i < 16; ++i) O[dt][i] *= alpha;
      }
#pragma unroll
      for (int s2 = 0; s2 < 2; ++s2) {
        u32x4 u;
        u.x = pk_bf16(S[8 * s2 + 0], S[8 * s2 + 1]); u.y = pk_bf16(S[8 * s2 + 2], S[8 * s2 + 3]);
        u.z = pk_bf16(S[8 * s2 + 4], S[8 * s2 + 5]); u.w = pk_bf16(S[8 * s2 + 6], S[8 * s2 + 7]);
        pf[s2] = __builtin_bit_cast(bf16x8, u);
      }
#pragma unroll
      for (int dt = 0; dt < 2; ++dt)
#pragma unroll
        for (int s2 = 0; s2 < 2; ++s2) {
          const char* va = sV + ((dt * 32 + lr) * 72 + kk * 32 + 16 * s2 + 4 * h) * 2;
          const uint2 v0 = *(const uint2*)va, v1 = *(const uint2*)(va + 16);
          u32x4 u; u.x = v0.x; u.y = v0.y; u.z = v1.x; u.w = v1.y;
          O[dt] = mfma32(__builtin_bit_cast(bf16x8, u), pf[s2], O[dt]);
        }
    }
  };
  char* const w0 = lds + (r0 * 72 + c8 * 8) * 2;
  char* const w1 = w0 + 18432;
  ALOAD1(0);
  ALOAD0(1);
  AWRITE1(w0);
  ALOAD1(2);
  __syncthreads();
  for (int kt = 0; kt < nkt - 2; kt += 2) {
    tile(lds);
    AWRITE0(w1);
    { const int kn = (kt + 3 < nkt) ? kt + 3 : nkt - 1; ALOAD0(kn); }
    __syncthreads();
    tile(lds + 18432);
    AWRITE1(w0);
    { const int kn = (kt + 4 < nkt) ? kt + 4 : nkt - 1; ALOAD1(kn); }
    __syncthreads();
  }
  tile(lds);
  AWRITE0(w1);
  __syncthreads();
  tile(lds + 18432);
  __syncthreads();
#undef ALOAD0
#undef ALOAD1
#undef AWRITE0
#undef AWRITE1
  const int tok = tok0 + qrow + lr;
  const float inv = 1.f / (lsum + __shfl_xor(lsum, 32));
  if (NC == 1) {
    float* Ot = (float*)lds + wave * (32 * 68);
#pragma unroll
    for (int dt = 0; dt < 2; ++dt)
#pragma unroll
      for (int q = 0; q < 4; ++q)
        *(float4*)(Ot + lr * 68 + dt * 32 + q * 8 + h * 4) = make_float4(O[dt][q * 4] * inv, O[dt][q * 4 + 1] * inv, O[dt][q * 4 + 2] * inv, O[dt][q * 4 + 3] * inv);
    attn_rows_out(p, Ot, tok0 + qrow, head * 64, nullptr, lane);
  } else {
    float* ex = (float*)lds + (size_t)(wave & 1) * 2048 + lane;
    if (comp == 1) {
#pragma unroll
      for (int dt = 0; dt < 2; ++dt)
#pragma unroll
        for (int i = 0; i < 16; ++i) ex[(dt * 16 + i) * 64] = O[dt][i] * inv;
    }
    __syncthreads();
    if (comp == 0) {
      float d1 = p.lq1[l * 32 + lr] * p.lk1[l * 32 + lr], d2 = p.lq2[l * 32 + lr] * p.lk2[l * 32 + lr];
#pragma unroll
      for (int o = 16; o > 0; o >>= 1) { d1 += __shfl_xor(d1, o); d2 += __shfl_xor(d2, o); }
      const float lam_init = (l == 0) ? 0.2f : 0.35550907f;
      const float lam = expf(d1) - expf(d2) + lam_init;
      float ss = 0.f;
#pragma unroll
      for (int dt = 0; dt < 2; ++dt)
#pragma unroll
        for (int i = 0; i < 16; ++i) { O[dt][i] = O[dt][i] * inv - lam * ex[(dt * 16 + i) * 64]; ss += O[dt][i] * O[dt][i]; }
      ss += __shfl_xor(ss, 32);
      const float r = rsqrtf(ss * (1.f / 64.f) + EPS) * (1.f - lam_init);
      float* Ot = (float*)(lds + 16384) + (wave & 1) * (32 * 68);
#pragma unroll
      for (int dt = 0; dt < 2; ++dt)
#pragma unroll
        for (int q = 0; q < 4; ++q)
          *(float4*)(Ot + lr * 68 + dt * 32 + q * 8 + h * 4) = make_float4(O[dt][q * 4] * r, O[dt][q * 4 + 1] * r, O[dt][q * 4 + 2] * r, O[dt][q * 4 + 3] * r);
      attn_rows_out(p, Ot, tok0 + qrow, 512 + head * 64, p.subln_g + l * 64, lane);
    }
    __syncthreads();
  }
}

DEVI void att_phase_unit(const Params& p, int l, int u, char* lds) {
  if (u < 64) { const int j = u >> 4, mt = (u >> 1) & 7, nt = u & 1; fourier_tile(p, NCTX + j * 1024, 1024, 32ull * 131072 + (size_t)j * 524288, mt, nt, lds); return; }
  u -= 64;
  if (u < 256) { const int j = u >> 6, head = (u >> 3) & 7, qb = u & 7; attn_unit<1>(p, l, NCTX + j * 1024 + qb * 128, head, lds); return; }
  u -= 256;
  if (u < 256) { const int j = u >> 6, head = (u >> 4) & 3, qb = u & 15; attn_unit<2>(p, l, NCTX + j * 1024 + qb * 64, head, lds); return; }
  u -= 256;
  if (u < 128) { const int b = u >> 2, mt = (u >> 1) & 1, nt = u & 1; fourier_tile(p, b * 256, 256, (size_t)b * 131072, mt, nt, lds); return; }
  u -= 128;
  if (u < 512) { const int b = u >> 4, head = (u >> 1) & 7, qb = u & 1; attn_unit<1>(p, l, b * 256 + qb * 128, head, lds); return; }
  u -= 512;
  { const int b = u >> 4, head = (u >> 2) & 3, qb = u & 3; attn_unit<2>(p, l, b * 256 + qb * 64, head, lds); }
}
constexpr int ATT_UNITS = 256 + 256 + 64 + 512 + 512 + 128;

DEVI void p0a(const Params& p, char* lds) {
  const int t = tid(), nb = gridDim.x, bid = blockIdx.x;
  float* lf = (float*)lds;
  {
    float* sl = lf;
    float* red = lf + 5120;
    bool loaded = false;
    for (int it = bid; it < 384; it += nb) {
      if (!loaded) {
        const float* ca = opq(p.c_ctx); const float* cb = opq(p.c);
        for (int cnd = 0; cnd < 5; ++cnd) {
          const float4 v = *(const float4*)((cnd == 0 ? ca : cb + (cnd - 1) * 1024) + t * 4);
          *(float4*)(sl + cnd * 1024 + t * 4) = make_float4(v.x / (1.f + expf(-v.x)), v.y / (1.f + expf(-v.y)), v.z / (1.f + expf(-v.z)), v.w / (1.f + expf(-v.w)));
        }
        loaded = true;
        __syncthreads();
      }
      const int l = it / 192, cb16 = it % 192, c4 = t & 3, kg = t >> 2;
      const float* wp = p.w_mod + (size_t)l * 1024 * 3072 + cb16 * 16 + c4 * 4 + (size_t)kg * 3072;
      float4 w[16];
#pragma unroll
      for (int i = 0; i < 16; ++i) w[i] = *(const float4*)(wp + (size_t)(64 * i) * 3072);
      float a[5][4];
#pragma unroll
      for (int cnd = 0; cnd < 5; ++cnd)
#pragma unroll
        for (int e = 0; e < 4; ++e) a[cnd][e] = 0.f;
#pragma unroll
      for (int i = 0; i < 16; ++i)
#pragma unroll
        for (int cnd = 0; cnd < 5; ++cnd) { const float sv = sl[cnd * 1024 + kg + 64 * i]; a[cnd][0] += sv * w[i].x; a[cnd][1] += sv * w[i].y; a[cnd][2] += sv * w[i].z; a[cnd][3] += sv * w[i].w; }
#pragma unroll
      for (int cnd = 0; cnd < 5; ++cnd)
#pragma unroll
        for (int e = 0; e < 4; ++e) red[(kg * 5 + cnd) * 16 + c4 * 4 + e] = a[cnd][e];
      __syncthreads();
      if (t < 80) {
        const int cnd = t >> 4, col = t & 15;
        float sum = p.b_mod[l * 3072 + cb16 * 16 + col];
        for (int g = 0; g < 64; ++g) sum += red[(g * 5 + cnd) * 16 + col];
        ((float*)(p.ws + OFF_MOD))[(size_t)(l * 5 + cnd) * 3072 + cb16 * 16 + col] = sum;
      }
      __syncthreads();
    }
    __syncthreads();
  }
  {
    constexpr int NIT = 1280 + 512 + 384;
    auto decode = [&](int it, const float*& src, bf16_t*& dst, int& ld, int& ldd) {
      if (it < 1280) {
        const int l = it / 640, r = it % 640, nt = r >> 4, kt = r & 15;
        const int sn0 = nt < 36 ? nt * 64 : 2560 + (nt - 36) * 64, dn0 = nt < 36 ? nt * 64 : 2816 + (nt - 36) * 64;
        src = p.w_in + (size_t)l * 1024 * 2816 + (size_t)(kt * 64) * 2816 + sn0; ld = 2816; ldd = LDP;
        dst = (bf16_t*)(p.ws + OFF_WTIN) + (size_t)l * 3072 * LDP + (size_t)dn0 * LDP + kt * 64;
      } else if (it < 1792) {
        const int q = it - 1280, l = q >> 8, r = q & 255, nt = r >> 4, kt = r & 15;
        src = p.w_out + (size_t)l * 1024 * 1024 + (size_t)(kt * 64) * 1024 + nt * 64; ld = 1024; ldd = LDP;
        dst = (bf16_t*)(p.ws + OFF_WTOUT) + (size_t)l * 1024 * LDP + (size_t)(nt * 64) * LDP + kt * 64;
      } else if (it < 1792 + 128) {
        const int q = it - 1792, j = q >> 5, l = (q >> 4) & 1, pt = (q >> 1) & 7, kvh = q & 1;
        src = p.cache_a + ((size_t)((j * 2 + l) * 512 + pt * 64) * 2 + 1) * 128 + kvh * 64; ld = 256; ldd = 1536;
        dst = (bf16_t*)(p.ws + OFF_VTA) + (size_t)l * KA_L + 1048576 + (size_t)j * 196608 + (size_t)(kvh * 64) * 1536 + 1024 + pt * 64;
      } else {
        const int q = it - 1920, j = q >> 6, l = (q >> 5) & 1, pt = (q >> 2) & 7, hh = q & 3;
        src = p.cache_b + ((size_t)((j * 2 + l) * 512 + pt * 64) * 2 + 1) * 256 + hh * 64; ld = 512; ldd = 1536;
        dst = (bf16_t*)(p.ws + OFF_VTB) + (size_t)l * KB_L + 2097152 + (size_t)j * 393216 + (size_t)(hh * 64) * 1536 + 1024 + pt * 64;
      }
    };
    float* lf2 = lf + 64 * 65;
    for (int it = bid; it < NIT; it += 2 * nb) {
      const bool hasB = it + nb < NIT;
      const float *srcA, *srcB; bf16_t *dstA, *dstB; int ldA, lddA, ldB, lddB;
      decode(it, srcA, dstA, ldA, lddA);
      decode(hasB ? it + nb : it, srcB, dstB, ldB, lddB);
      {
        const int col = t & 63, rw = t >> 6;
        float va[16], vb[16];
#pragma unroll
        for (int i = 0; i < 16; ++i) { va[i] = srcA[(size_t)(rw + 4 * i) * ldA + col]; vb[i] = srcB[(size_t)(rw + 4 * i) * ldB + col]; }
#pragma unroll
        for (int i = 0; i < 16; ++i) { lf[(rw + 4 * i) * 65 + col] = va[i]; lf2[(rw + 4 * i) * 65 + col] = vb[i]; }
      }
      __syncthreads();
      {
        const int n = t >> 2, kc = (t & 3) * 16;
        uint32_t w[8];
#pragma unroll
        for (int j = 0; j < 8; ++j) w[j] = pk_bf16(lf[(kc + 2 * j) * 65 + n], lf[(kc + 2 * j + 1) * 65 + n]);
        uint4* d = (uint4*)(dstA + (size_t)n * lddA + kc);
        d[0] = make_uint4(w[0], w[1], w[2], w[3]); d[1] = make_uint4(w[4], w[5], w[6], w[7]);
        if (hasB) {
#pragma unroll
          for (int j = 0; j < 8; ++j) w[j] = pk_bf16(lf2[(kc + 2 * j) * 65 + n], lf2[(kc + 2 * j + 1) * 65 + n]);
          uint4* d2 = (uint4*)(dstB + (size_t)n * lddB + kc);
          d2[0] = make_uint4(w[0], w[1], w[2], w[3]); d2[1] = make_uint4(w[4], w[5], w[6], w[7]);
        }
      }
      __syncthreads();
    }
  }
  {
    if (t < 64) { lf[t] = cospif((float)t / 32.f); lf[64 + t] = sinpif((float)t / 32.f); }
    __syncthreads();
    for (int gid = bid * NTHREADS + t; gid < 2 * 256 * 512; gid += nb * NTHREADS) {
      const int l = gid >> 17, r = (gid >> 9) & 255, n = gid & 511, comp = n >> 8, nn = n & 255, g = r >> 6, cc = r & 63;
      const float* wc = p.w_c + (size_t)l * 65536 + (size_t)(g * 64) * 256 + nn;
      const float* tb = lf + comp * 64;
      float s = 0.f;
      float wv[64];
#pragma unroll
      for (int c2 = 0; c2 < 64; ++c2) wv[c2] = wc[(size_t)c2 * 256];
#pragma unroll
      for (int c2 = 0; c2 < 64; ++c2) s += tb[(cc * c2) & 63] * wv[c2];
      ((float*)(p.ws + OFF_W12))[gid] = s;
    }
    __syncthreads();
  }
  for (int gid = bid * NTHREADS + t; gid < 256 * 512; gid += nb * NTHREADS) {
    const int sp = gid >> 9, k = gid & 511, kk = k & 255, m = (sp * kk) & 255;
    const float ang = (float)m / 128.f;
    const float v = (k < 256 ? cospif(ang) : -sinpif(ang)) * (1.f / 128.f);
    ((bf16_t*)(p.ws + OFF_T256))[gid] = f2bf(v);
  }
  for (int gid = bid * NTHREADS + t; gid < 1024 * 2048; gid += nb * NTHREADS) {
    const int sp = gid >> 11, k = gid & 2047, kk = k & 1023, m = (sp * kk) & 1023;
    const float ang = (float)m / 512.f;
    const float v = (k < 1024 ? cospif(ang) : -sinpif(ang)) * (1.f / 256.f);
    ((bf16_t*)(p.ws + OFF_T1024))[gid] = f2bf(v);
  }
  for (int gid = bid * NTHREADS + t; gid < 1024 * 32; gid += nb * NTHREADS) {
    const int s = gid >> 5, j = gid & 31, f = j & 15;
    const float pos = (float)(j < 16 ? (s >> 6) : (s & 63));
    const float inv = 1.0f / powf(10000.f, (float)f / 16.f);
    const float ang = pos * inv;
    float* R = (float*)(p.ws + OFF_ROPEA);
    R[gid] = cosf(ang); R[1024 * 32 + gid] = sinf(ang);
  }
  for (int gid = bid * NTHREADS + t; gid < 1024 * 16; gid += nb * NTHREADS) {
    const int s = gid >> 4, j = gid & 15, f = j & 7;
    const float pos = (float)(j < 8 ? (s >> 6) : (s & 63));
    const float inv = 1.0f / powf(10000.f, (float)f / 8.f);
    const float ang = pos * inv;
    float* R = (float*)(p.ws + OFF_ROPEB);
    R[gid] = cosf(ang); R[1024 * 16 + gid] = sinf(ang);
  }
  float km0 = 0.f, km1 = 0.f, km2 = 0.f, km3 = 0.f;
  {
    const int stride = nb * NTHREADS;
    auto conv_a = [&](int gid, float v) {
      const int cd = gid & 127, pp = (gid >> 7) & 511, l = (gid >> 16) & 1, j = gid >> 17;
      ((bf16_t*)(p.ws + OFF_KA))[(size_t)l * KA_L + (size_t)(NCTX + j * 1536 + 1024 + pp) * 128 + cd] = f2bf(v);
      float ss = v * v;
#pragma unroll
      for (int o = 32; o > 0; o >>= 1) ss += __shfl_xor(ss, o);
      if (l == 0) km0 = fmaxf(km0, ss); else km2 = fmaxf(km2, ss);
    };
    auto src_a = [&](int gid) { return p.cache_a[((size_t)(gid >> 7) * 2) * 128 + (gid & 127)]; };
    int gid = bid * NTHREADS + t;
    for (; gid + 3 * stride < 524288; gid += 4 * stride) {
      const float v0 = src_a(gid), v1 = src_a(gid + stride), v2 = src_a(gid + 2 * stride), v3 = src_a(gid + 3 * stride);
      conv_a(gid, v0); conv_a(gid + stride, v1); conv_a(gid + 2 * stride, v2); conv_a(gid + 3 * stride, v3);
    }
    for (; gid < 524288; gid += stride) conv_a(gid, src_a(gid));
    auto conv_b = [&](int g2, float v) {
      const int cd = g2 & 255, pp = (g2 >> 8) & 511, l = (g2 >> 17) & 1, j = g2 >> 18;
      ((bf16_t*)(p.ws + OFF_KB))[(size_t)l * KB_L + (size_t)(NCTX + j * 1536 + 1024 + pp) * 256 + cd] = f2bf(v);
      float ss = v * v;
#pragma unroll
      for (int o = 16; o > 0; o >>= 1) ss += __shfl_xor(ss, o);
      if (l == 0) km1 = fmaxf(km1, ss); else km3 = fmaxf(km3, ss);
    };
    auto src_b = [&](int g2) { return p.cache_b[((size_t)(g2 >> 8) * 2) * 256 + (g2 & 255)]; };
    gid = bid * NTHREADS + t;
    for (; gid + 3 * stride < 1048576; gid += 4 * stride) {
      const float v0 = src_b(gid), v1 = src_b(gid + stride), v2 = src_b(gid + 2 * stride), v3 = src_b(gid + 3 * stride);
      conv_b(gid, v0); conv_b(gid + stride, v1); conv_b(gid + 2 * stride, v2); conv_b(gid + 3 * stride, v3);
    }
    for (; gid < 1048576; gid += stride) conv_b(gid, src_b(gid));
  }
  {
    km1 = fmaxf(km1, __shfl_xor(km1, 32)); km3 = fmaxf(km3, __shfl_xor(km3, 32));
    __syncthreads();
    if ((t & 63) == 0) { float* sm = lf + (t >> 6) * 4; sm[0] = km0; sm[1] = km1; sm[2] = km2; sm[3] = km3; }
    __syncthreads();
    if (t < 4) ((float*)(p.ws + OFF_KMAXP))[bid * 4 + t] = fmaxf(fmaxf(lf[t], lf[4 + t]), fmaxf(lf[8 + t], lf[12 + t]));
    __syncthreads();
  }
}

DEVI void p0b(const Params& p, char* lds) {
  const int t = tid(), nb = gridDim.x, bid = blockIdx.x;
  float* lf = (float*)lds;
  for (int it = bid; it < 256; it += nb) {
    const int l = it >> 7, kt = (it >> 3) & 15, ntl = it & 7;
    const float* U = p.w_in + (size_t)l * 1024 * 2816 + (size_t)(kt * 64) * 2816 + 2304;
    const float* W = (const float*)(p.ws + OFF_W12) + (size_t)l * 256 * 512 + ntl * 64;
    float* Us = lf;
    float* Ws = lf + 64 * 33;
    const int tk = t >> 4, tn = t & 15;
    float a[4][4];
#pragma unroll
    for (int i = 0; i < 4; ++i)
#pragma unroll
      for (int j = 0; j < 4; ++j) a[i][j] = 0.f;
    for (int rc = 0; rc < 8; ++rc) {
#pragma unroll
      for (int i = 0; i < 8; ++i) { const int e = t + 256 * i, kk = e >> 5, rr = e & 31; Us[kk * 33 + rr] = U[(size_t)kk * 2816 + rc * 32 + rr]; }
#pragma unroll
      for (int i = 0; i < 8; ++i) { const int e = t + 256 * i, rr = e >> 6, nn = e & 63; Ws[rr * 64 + nn] = W[(size_t)(rc * 32 + rr) * 512 + nn]; }
      __syncthreads();
#pragma unroll 8
      for (int r = 0; r < 32; ++r) {
        const float4 w = *(const float4*)(Ws + r * 64 + tn * 4);
#pragma unroll
        for (int i = 0; i < 4; ++i) { const float u = Us[(tk * 4 + i) * 33 + r]; a[i][0] += u * w.x; a[i][1] += u * w.y; a[i][2] += u * w.z; a[i][3] += u * w.w; }
      }
      __syncthreads();
    }
    bf16_t* dst = (bf16_t*)(p.ws + OFF_WTIN) + (size_t)l * 3072 * LDP + (size_t)(2304 + ntl * 64 + tn * 4) * LDP + kt * 64 + tk * 4;
#pragma unroll
    for (int j = 0; j < 4; ++j) st_bf4(dst + (size_t)j * LDP, a[0][j], a[1][j], a[2][j], a[3][j]);
    {
      float* red = lf;
#pragma unroll
      for (int cnd = 0; cnd < 5; ++cnd) {
        const float4 sh = *(const float4*)((const float*)(p.ws + OFF_MOD) + (size_t)(l * 5 + cnd) * 3072 + kt * 64 + tk * 4);
#pragma unroll
        for (int j = 0; j < 4; ++j) red[(tk * 5 + cnd) * 64 + tn * 4 + j] = sh.x * a[0][j] + sh.y * a[1][j] + sh.z * a[2][j] + sh.w * a[3][j];
      }
      __syncthreads();
      for (int o = t; o < 320; o += NTHREADS) {
        const int cnd = o >> 6, n = o & 63;
        float sum = 0.f;
#pragma unroll
        for (int g = 0; g < 16; ++g) sum += red[(g * 5 + cnd) * 64 + n];
        ((float*)(p.ws + OFF_SHWP))[((size_t)(l * 16 + kt) * 5 + cnd) * 512 + ntl * 64 + n] = sum;
      }
      __syncthreads();
    }
  }
  {
    const int lane = t & 63, wave = t >> 6;
    const float* MOD = (const float*)(p.ws + OFF_MOD);
    for (int row = bid * 4 + wave; row < NTOK; row += nb * 4) {
      const float* xa = opq(p.x_prompt); const float* xb = opq(p.x_sample);
      const float* x = row < NCTX ? xa + (size_t)row * 1024 : xb + (size_t)(row - NCTX) * 1024;
      const int cond = row < NCTX ? 0 : 1 + ((row - NCTX) >> 10);
      const float* sc = MOD + (size_t)cond * 3072 + 1024;
      bf16_t* hp = (bf16_t*)(p.ws + OFF_HP) + (size_t)row * LDP;
      float ss = 0.f;
      float4 xv[4], gv[4], sv[4];
#pragma unroll
      for (int i = 0; i < 4; ++i) { const int k = i * 256 + lane * 4; xv[i] = *(const float4*)(x + k); gv[i] = *(const float4*)(p.norm_g + k); sv[i] = *(const float4*)(sc + k); }
#pragma unroll
      for (int i = 0; i < 4; ++i) {
        const int k = i * 256 + lane * 4;
        ss += xv[i].x * xv[i].x + xv[i].y * xv[i].y + xv[i].z * xv[i].z + xv[i].w * xv[i].w;
        st_bf4(hp + k, xv[i].x * gv[i].x * (1.f + sv[i].x), xv[i].y * gv[i].y * (1.f + sv[i].y), xv[i].z * gv[i].z * (1.f + sv[i].z), xv[i].w * gv[i].w * (1.f + sv[i].w));
      }
#pragma unroll
      for (int o = 32; o > 0; o >>= 1) ss += __shfl_xor(ss, o);
      if (lane < 16) ((float*)(p.ws + OFF_SSQ))[(size_t)row * 16 + lane] = lane == 0 ? ss : 0.f;
    }
  }
  {
  const int lane = t & 63, wave = t >> 6;
  if (blockIdx.x == 0 && wave == 0) {
    const float4* pp = (const float4*)(p.ws + OFF_KMAXP);
    float4 m = make_float4(0.f, 0.f, 0.f, 0.f);
    for (int i = lane; i < (int)gridDim.x; i += 64) { const float4 v = pp[i]; m.x = fmaxf(m.x, v.x); m.y = fmaxf(m.y, v.y); m.z = fmaxf(m.z, v.z); m.w = fmaxf(m.w, v.w); }
#pragma unroll
    for (int o = 32; o > 0; o >>= 1) { m.x = fmaxf(m.x, __shfl_xor(m.x, o)); m.y = fmaxf(m.y, __shfl_xor(m.y, o)); m.z = fmaxf(m.z, __shfl_xor(m.z, o)); m.w = fmaxf(m.w, __shfl_xor(m.w, o)); }
    if (lane == 0) *(float4*)(p.ws + OFF_KMAX) = m;
  }
  const float* MOD = (const float*)(p.ws + OFF_MOD);
  for (int idx = blockIdx.x * 4 + wave; idx < 2 * 2560; idx += gridDim.x * 4) {
    const int l = idx / 2560, n2 = idx % 2560, n = n2 < 2304 ? n2 : n2 + 512;
    const bf16_t* w = (const bf16_t*)(p.ws + OFF_WTIN) + (size_t)l * 3072 * LDP + (size_t)n * LDP + lane * 16;
    const uint4 w0 = *(const uint4*)w, w1 = *(const uint4*)(w + 8);
    float wf[16];
    wf[0] = __uint_as_float(w0.x << 16); wf[1] = __uint_as_float(w0.x & 0xffff0000u); wf[2] = __uint_as_float(w0.y << 16); wf[3] = __uint_as_float(w0.y & 0xffff0000u);
    wf[4] = __uint_as_float(w0.z << 16); wf[5] = __uint_as_float(w0.z & 0xffff0000u); wf[6] = __uint_as_float(w0.w << 16); wf[7] = __uint_as_float(w0.w & 0xffff0000u);
    wf[8] = __uint_as_float(w1.x << 16); wf[9] = __uint_as_float(w1.x & 0xffff0000u); wf[10] = __uint_as_float(w1.y << 16); wf[11] = __uint_as_float(w1.y & 0xffff0000u);
    wf[12] = __uint_as_float(w1.z << 16); wf[13] = __uint_as_float(w1.z & 0xffff0000u); wf[14] = __uint_as_float(w1.w << 16); wf[15] = __uint_as_float(w1.w & 0xffff0000u);
#pragma unroll
    for (int cnd = 0; cnd < 5; ++cnd) {
      const float* sh = MOD + (size_t)(l * 5 + cnd) * 3072 + lane * 16;
      float s = 0.f;
#pragma unroll
      for (int i = 0; i < 4; ++i) { const float4 s4 = *(const float4*)(sh + i * 4); s += s4.x * wf[i * 4] + s4.y * wf[i * 4 + 1] + s4.z * wf[i * 4 + 2] + s4.w * wf[i * 4 + 3]; }
#pragma unroll
      for (int o = 32; o > 0; o >>= 1) s += __shfl_xor(s, o);
      if (lane == 0) ((float*)(p.ws + OFF_SHW))[(size_t)(l * 5 + cnd) * 3072 + n] = s;
    }
  }
  }
}

constexpr int NPHASES = 8;
DEVI void run_phase(const Params& p, int ph, char* lds) {
  if (ph == 0) { p0a(p, lds); return; }
  if (ph == 1) { p0b(p, lds); return; }
  const int l = (ph - 2) / 3, k = (ph - 2) % 3;
  if (k == 0) {
    for (int it = blockIdx.x; it < 96 * 24; it += gridDim.x) { const int nt = it / 96, mt = it % 96; g1_tile(p, l, mt, nt, lds); }
  } else if (k == 1) {
#if COOP
    unsigned* ctr = (unsigned*)(p.ws + OFF_BAR + 14336) + l * 64;
    volatile LAS unsigned* sh = (volatile LAS unsigned*)(lds + LDS_BYTES) + 2;
    for (;;) {
      if (threadIdx.x == 0) sh[0] = __hip_atomic_fetch_add(ctr, 1u, __ATOMIC_RELAXED, __HIP_MEMORY_SCOPE_AGENT);
      __syncthreads();
      const int u = (int)sh[0];
      __syncthreads();
      if (u >= ATT_UNITS) break;
      att_phase_unit(p, l, u, lds);
    }
#else
    for (int u = blockIdx.x; u < ATT_UNITS; u += gridDim.x) att_phase_unit(p, l, u, lds);
#endif
  } else {
    for (int it = blockIdx.x; it < 1024; it += gridDim.x) {
      const int x = it & 7;
      if (it < 512) { const int j = it >> 3, nt = j & 7, mt = (j >> 3) * 8 + x; g2_tile(p, l, mt, nt, lds); }
      else { const int jj = (it - 512) >> 3, j = 64 + (jj >> 1), nt = j & 7, mt = (j >> 3) * 8 + x; g2_half_tile(p, l, mt, nt * 2 + (jj & 1), lds); }
    }
  }
}

__global__ void __launch_bounds__(NTHREADS, 2) __attribute__((amdgpu_waves_per_eu(2, 2))) fwd_mega(Params p) {
  extern __shared__ __attribute__((aligned(16))) char lds[];
  cg::grid_group grid = cg::this_grid();
  if (p.ws == nullptr) grid.sync();
  volatile LAS unsigned* st = (volatile LAS unsigned*)(lds + LDS_BYTES);
  if (threadIdx.x == 0) { st[0] = 0u; st[1] = 0u; }
  __syncthreads();
  XcdBarrier xb = xcd_barrier_post((unsigned*)(p.ws + OFF_BAR), st);
  for (int ph = 0; ph < NPHASES; ++ph) {
#if DUPMASK
    if ((DUPMASK >> ph) & 1) { run_phase(p, ph, lds); xcd_barrier(xb); }
#endif
    run_phase(p, ph, lds);
    if (ph + 1 < NPHASES) xcd_barrier(xb);
  }
}

__global__ void __launch_bounds__(NTHREADS, 2) __attribute__((amdgpu_waves_per_eu(2, 2))) fwd_phase(Params p, int ph) {
  extern __shared__ __attribute__((aligned(16))) char lds[];
  run_phase(p, ph, lds);
}

extern "C" void kernel_launch(void* const* d_in, const int* in_sizes, int n_in, void* d_out, int out_size, void* d_ws, size_t ws_size, hipStream_t stream) {
  static int grid_blocks = 0;
  if (!grid_blocks) {
    int dev = 0, cus = 0, per_cu = 0;
    hipGetDevice(&dev);
    hipDeviceGetAttribute(&cus, hipDeviceAttributeMultiprocessorCount, dev);
#if COOP
    hipFuncSetAttribute((const void*)fwd_mega, hipFuncAttributeMaxDynamicSharedMemorySize, LDS_TOTAL);
    hipOccupancyMaxActiveBlocksPerMultiprocessor(&per_cu, (const void*)fwd_mega, NTHREADS, LDS_TOTAL);
    fprintf(stderr, "occupancy query: %d blocks per CU, %d CUs\n", per_cu, cus);
    per_cu = 2;
#else
    hipFuncSetAttribute((const void*)fwd_phase, hipFuncAttributeMaxDynamicSharedMemorySize, LDS_BYTES);
    hipOccupancyMaxActiveBlocksPerMultiprocessor(&per_cu, (const void*)fwd_phase, NTHREADS, LDS_BYTES);
#endif
    if (per_cu < 1) per_cu = 1;
    if (per_cu > 2) per_cu = 2;
    grid_blocks = cus * per_cu;
    if (ws_size < WS_END) fprintf(stderr, "workspace too small: %zu < %zu\n", ws_size, (size_t)WS_END);
  }
  Params p{};
  const float** pp = (const float**)&p;
  for (int i = 0; i < 21; ++i) pp[i] = (const float*)d_in[i];
  p.out = (float*)d_out;
  p.ws = (char*)d_ws;
#if COOP
  void* args[] = {&p};
  hipMemsetAsync((char*)d_ws + OFF_BAR, 0, 16384, stream);
  hipError_t e = hipLaunchCooperativeKernel((const void*)fwd_mega, dim3(grid_blocks), dim3(NTHREADS), args, LDS_TOTAL, stream);
  if (e != hipSuccess) fprintf(stderr, "cooperative launch failed: %s (grid %d)\n", hipGetErrorString(e), grid_blocks);
#else
  for (int ph = 0; ph < NPHASES; ++ph) hipLaunchKernelGGL(fwd_phase, dim3(grid_blocks), dim3(NTHREADS), LDS_BYTES, stream, p, ph);
#endif
}
```

```cpp
#include <hip/hip_runtime.h>
#include <hip/hip_cooperative_groups.h>
#include <stdint.h>
#include <cstdio>
namespace cg = cooperative_groups;

#ifndef COOP
#define COOP 1
#endif
#ifndef DUPMASK
#define DUPMASK 0
#endif

typedef unsigned short bf16_t;
typedef short bf16x8 __attribute__((ext_vector_type(8)));
typedef float f32x16 __attribute__((ext_vector_type(16)));
typedef uint32_t u32x4 __attribute__((ext_vector_type(4)));
#define DEVI __device__ __forceinline__

constexpr int NTOK = 12288, NCTX = 8192, DM = 1024, N1 = 3072;
constexpr int NTHREADS = 256;
constexpr int LDP = 1088;
constexpr int LDS_BYTES = 73728;
constexpr int LDS_TOTAL = LDS_BYTES + 16;
constexpr float EPS = 1e-6f;
constexpr float LOG2E = 1.4426950408889634f;

constexpr size_t OFF_WTIN  = 0;
constexpr size_t OFF_WTOUT = OFF_WTIN  + 2ull * 3072 * LDP * 2;
constexpr size_t OFF_W12   = OFF_WTOUT + 2ull * 1024 * LDP * 2;
constexpr size_t OFF_T256  = OFF_W12   + 2ull * 256 * 512 * 4;
constexpr size_t OFF_T1024 = OFF_T256  + 256ull * 512 * 2;
constexpr size_t OFF_ROPEA = OFF_T1024 + 1024ull * 2048 * 2;
constexpr size_t OFF_ROPEB = OFF_ROPEA + 2ull * 1024 * 32 * 4;
constexpr size_t OFF_MOD   = OFF_ROPEB + 2ull * 1024 * 16 * 4;
constexpr size_t OFF_SHW   = OFF_MOD   + 2ull * 5 * 3072 * 4;
constexpr size_t OFF_SSQ   = OFF_SHW   + 2ull * 5 * 3072 * 4;
constexpr size_t OFF_HP    = OFF_SSQ   + 12288ull * 16 * 4;
constexpr size_t OFF_QA    = OFF_HP    + 12288ull * LDP * 2;
constexpr size_t OFF_KA    = OFF_QA    + 12288ull * 512 * 2;
constexpr size_t OFF_VTA   = OFF_KA    + 2ull * 14336 * 128 * 2;
constexpr size_t OFF_QB    = OFF_VTA   + 2ull * 14336 * 128 * 2;
constexpr size_t OFF_KB    = OFF_QB    + 12288ull * 256 * 2;
constexpr size_t OFF_VTB   = OFF_KB    + 2ull * 14336 * 256 * 2;
constexpr size_t OFF_G     = OFF_VTB   + 2ull * 14336 * 256 * 2;
constexpr size_t OFF_PQT   = OFF_G     + 12288ull * 1024 * 2;
constexpr size_t OFF_MIX   = OFF_PQT   + 12288ull * 512 * 2;
constexpr size_t OFF_Y1    = OFF_MIX   + 12288ull * LDP * 2;
constexpr size_t OFF_BAR   = OFF_Y1    + 12288ull * 1024 * 4;
constexpr size_t OFF_KMAX  = OFF_BAR   + 16384;
constexpr size_t OFF_KMAXP = OFF_KMAX  + 256;
constexpr size_t OFF_SHWP  = OFF_KMAXP + 16384;
constexpr size_t WS_END    = OFF_SHWP  + 2ull * 16 * 5 * 512 * 4;

constexpr size_t KA_L = 14336ull * 128, KB_L = 14336ull * 256;

struct Params {
  const float *x_prompt, *x_sample, *cache_a, *cache_b, *c, *c_ctx, *norm_g, *w_mod, *b_mod, *w_in,
      *qn_a, *kn_a, *qn_b, *kn_b, *lq1, *lk1, *lq2, *lk2, *subln_g, *w_c, *w_out;
  float* out;
  char* ws;
};

DEVI uint32_t pk_bf16(float lo, float hi) { uint32_t r; asm("v_cvt_pk_bf16_f32 %0, %1, %2" : "=v"(r) : "v"(lo), "v"(hi)); return r; }
DEVI bf16_t f2bf(float f) { return (bf16_t)(pk_bf16(f, 0.f) & 0xffffu); }
DEVI float bf2f(bf16_t b) { return __uint_as_float(((uint32_t)b) << 16); }
DEVI const float* opq(const float* x) { asm volatile("" : "+s"(x)); return x; }
DEVI int tid() { int t = threadIdx.x; asm volatile("" : "+v"(t)); return t; }
DEVI float silu(float v) { return v * __builtin_amdgcn_rcpf(1.f + __expf(-v)); }
DEVI f32x16 mfma32(bf16x8 a, bf16x8 b, f32x16 c) { return __builtin_amdgcn_mfma_f32_32x32x16_bf16(a, b, c, 0, 0, 0); }
DEVI void st_bf4(bf16_t* p, float a, float b, float c, float d) { uint2 u; u.x = pk_bf16(a, b); u.y = pk_bf16(c, d); *(uint2*)p = u; }


#define XB_TMO      128
#define XB_XCNT(j)  (256  + 64 * (j))
#define XB_XSUB(j)  (1280 + 64 * (j))
#define XB_XGEN(j)  (2304 + 64 * (j))
#define XB_TOP      3328
#define XB_TOPGEN   3392
#define XCD_BAR_WORDS 3456
#define XB_SPIN_CAP (1u << 20)
#define LAS __attribute__((address_space(3)))
DEVI unsigned xb_ld(unsigned* p)              { return __hip_atomic_load(p, __ATOMIC_RELAXED, __HIP_MEMORY_SCOPE_AGENT); }
DEVI unsigned xb_add(unsigned* p, unsigned v) { return __hip_atomic_fetch_add(p, v, __ATOMIC_RELAXED, __HIP_MEMORY_SCOPE_AGENT); }
DEVI unsigned xb_xcc_id() { return (unsigned)__builtin_amdgcn_s_getreg((3 << 11) | 20) & 0xFu; }
#define XB_SPIN(cond, bar) do { unsigned _sp = 0; while (cond) { __builtin_amdgcn_s_sleep(1); \
    if ((++_sp & 255u) == 0u) { if (xb_ld(&(bar)[XB_TMO])) break; if (_sp > XB_SPIN_CAP) { atomicAdd(&(bar)[XB_TMO], 1u); break; } } } } while (0)
struct XcdBarrier { unsigned* bar; unsigned x; volatile LAS unsigned* st; };
DEVI XcdBarrier xcd_barrier_post(unsigned* bar, volatile LAS unsigned* st) {
  XcdBarrier b; b.bar = bar; b.x = xb_xcc_id(); b.st = st;
  if (threadIdx.x == 0) (void)xb_add(&bar[XB_XCNT(b.x)], 1u);
  return b;
}
DEVI void xcd_barrier_complete(unsigned* bar, unsigned x, unsigned& nloc, unsigned& nx) {
  const unsigned G = gridDim.x * gridDim.y * gridDim.z;
  unsigned sum, cnt, mine, sp = 0u;
  for (;;) {
    sum = 0u; cnt = 0u; mine = 0u;
#pragma unroll
    for (unsigned j = 0; j < 16; ++j) { const unsigned c = xb_ld(&bar[XB_XCNT(j)]); sum += c; cnt += (c > 0u) ? 1u : 0u; mine = (j == x) ? c : mine; }
    if (sum == G) break;
    __builtin_amdgcn_s_sleep(1);
    if ((++sp & 255u) == 0u) { if (xb_ld(&bar[XB_TMO])) break; if (sp > XB_SPIN_CAP) { atomicAdd(&bar[XB_TMO], 1u); break; } }
  }
  nloc = mine > 0u ? mine : 1u; nx = cnt > 0u ? cnt : 1u;
}
DEVI void xcd_barrier(const XcdBarrier& b) {
  asm volatile("s_waitcnt vmcnt(0)" ::: "memory");
  __syncthreads();
  if (threadIdx.x == 0) {
    unsigned* bar = b.bar;
    __builtin_amdgcn_s_waitcnt(0);
    unsigned nloc = b.st[0], nx = b.st[1];
    if (nloc == 0u) { xcd_barrier_complete(bar, b.x, nloc, nx); b.st[0] = nloc; b.st[1] = nx; }
    const unsigned old = xb_add(&bar[XB_XSUB(b.x)], 1u);
    const unsigned gen = old / nloc;
    if (old + 1u == (gen + 1u) * nloc) {
      __builtin_amdgcn_fence(__ATOMIC_RELEASE, "agent");
      asm volatile("s_waitcnt vmcnt(0)" ::: "memory");
      const unsigned og = xb_add(&bar[XB_TOP], 1u);
      const unsigned tg = og / nx;
      if (og + 1u == (tg + 1u) * nx) xb_add(&bar[XB_TOPGEN], 1u);
      else XB_SPIN(xb_ld(&bar[XB_TOPGEN]) == tg, bar);
      __builtin_amdgcn_fence(__ATOMIC_ACQUIRE, "agent");
      xb_add(&bar[XB_XGEN(b.x)], 1u);
      asm volatile("s_waitcnt vmcnt(0)" ::: "memory");
    } else {
      XB_SPIN(xb_ld(&bar[XB_XGEN(b.x)]) == gen, bar);
      __builtin_amdgcn_fence(__ATOMIC_ACQUIRE, "agent");
      asm volatile("s_waitcnt vmcnt(0)" ::: "memory");
    }
  }
  __syncthreads();
}

template <int TN = 2>
DEVI void gemm_core(const bf16_t* __restrict__ Ag, int lda, const bf16_t* __restrict__ Bg, int ldb, int K,
                    f32x16 (&acc)[TN][2], char* lds) {
  const int t = tid(), lane = t & 63, wave = t >> 6, wm = wave >> 1, wn = wave & 1;
  const int lr = lane & 31, h = lane >> 5;
#pragma unroll
  for (int a = 0; a < TN; ++a)
#pragma unroll
    for (int b = 0; b < 2; ++b)
#pragma unroll
      for (int i = 0; i < 16; ++i) acc[a][b][i] = 0.f;
  const int nk = K >> 6;
  const int r8 = lane >> 3, cp = lane & 7;
  const bf16_t* as_[4];
  const bf16_t* bs_[2 * TN];
#pragma unroll
  for (int i = 0; i < 4; ++i) { const int r = (wave * 4 + i) * 8 + r8; as_[i] = Ag + (size_t)r * lda + ((cp ^ ((r >> 1) & 7)) << 3); }
#pragma unroll
  for (int i = 0; i < 2 * TN; ++i) { const int r = (wave * 2 * TN + i) * 8 + r8; bs_[i] = Bg + (size_t)r * ldb + ((cp ^ ((r >> 1) & 7)) << 3); }
  LAS char* const l3a = (LAS char*)lds + wave * 4096;
  LAS char* const l3b = (LAS char*)lds + 16384 + wave * (2048 * TN);
#define GLDS(SRC, DST) __builtin_amdgcn_global_load_lds((const unsigned*)(SRC), (LAS unsigned*)(DST), 16, 0, 0)
#define DMA(BUF, KO) { \
    _Pragma("unroll") for (int i_ = 0; i_ < 4; ++i_) GLDS(as_[i_] + (KO), l3a + (BUF) * 32768 + i_ * 1024); \
    _Pragma("unroll") for (int i_ = 0; i_ < 2 * TN; ++i_) GLDS(bs_[i_] + (KO), l3b + (BUF) * 32768 + i_ * 1024); }
  const int swz = (lr >> 1) & 7;
  const int offA = (wm * 64 + lr) * 128, offB = 16384 + (wn * 32 * TN + lr) * 128;
#define COMPUTE(SA) { const char* s_ = (SA); \
    _Pragma("unroll") for (int ks = 0; ks < 4; ++ks) { bf16x8 fa[TN], fb[2]; const int co = ((ks * 2 + h) ^ swz) << 4; \
      _Pragma("unroll") for (int j = 0; j < 2; ++j) fb[j] = *(const bf16x8*)(s_ + offA + j * 4096 + co); \
      _Pragma("unroll") for (int j = 0; j < TN; ++j) fa[j] = *(const bf16x8*)(s_ + offB + j * 4096 + co); \
      _Pragma("unroll") for (int tn = 0; tn < TN; ++tn) _Pragma("unroll") for (int tm = 0; tm < 2; ++tm) acc[tn][tm] = mfma32(fa[tn], fb[tm], acc[tn][tm]); } }
  DMA(0, 0);
  asm volatile("s_waitcnt vmcnt(0)" ::: "memory");
  __syncthreads();
  for (int kt = 0; kt < nk; ++kt) {
    if (kt + 1 < nk) DMA((kt + 1) & 1, (kt + 1) * 64);
    COMPUTE(lds + (kt & 1) * 32768);
    asm volatile("s_waitcnt vmcnt(0)" ::: "memory");
    __syncthreads();
  }
#undef GLDS
#undef DMA
#undef COMPUTE
}

DEVI void g1_tile(const Params& p, int l, int mt, int nt, char* lds) {
  const int m0 = mt * 128, n0 = nt * 128;
  const bf16_t* HP = (const bf16_t*)(p.ws + OFF_HP);
  const bf16_t* WT = (const bf16_t*)(p.ws + OFF_WTIN) + (size_t)l * 3072 * LDP;
  const int t = tid(), lane = t & 63, wave = t >> 6, wm = wave >> 1, wn = wave & 1, lr = lane & 31, h = lane >> 5;
  const int nb = n0 + wn * 64;
  const bool lat = m0 >= NCTX;
  const int jb = lat ? ((m0 - NCTX) >> 10) : 0;
  const int cond = lat ? 1 + jb : 0;
  int type;
  if (n0 < 512) type = 0; else if (n0 < 640) type = 1; else if (n0 < 768) type = 2;
  else if (n0 < 1280) type = 3;
  else if (n0 < 1536) type = 4; else if (n0 < 1792) type = 5; else if (n0 < 2048) type = 6;
  else if (n0 < 2304) type = 3;
  else if (n0 < 2816) type = 7;
  else type = 3;
  float* X = (float*)(lds + 65536);
  if (t < 128) {
    const float4* sp = (const float4*)((const float*)(p.ws + OFF_SSQ) + (size_t)(m0 + t) * 16);
    const float4 a = sp[0], b = sp[1], c4 = sp[2], d = sp[3];
    const float ss = ((a.x + a.y) + (a.z + a.w)) + ((b.x + b.y) + (b.z + b.w)) + ((c4.x + c4.y) + (c4.z + c4.w)) + ((d.x + d.y) + (d.z + d.w));
    X[t] = rsqrtf(ss * (1.f / 1024.f) + EPS);
  } else {
    const int col = t - 128;
    float shv;
    if (type == 7) {
      const float* sp = (const float*)(p.ws + OFF_SHWP) + ((size_t)(l * 16) * 5 + cond) * 512 + (n0 - 2304) + col;
      shv = 0.f;
#pragma unroll
      for (int g = 0; g < 16; ++g) shv += sp[(size_t)g * 5 * 512];
    } else shv = ((const float*)(p.ws + OFF_SHW))[(size_t)(l * 5 + cond) * 3072 + n0 + col];
    X[128 + col] = shv;
    float g = 1.f;
    if (type == 0) g = p.qn_a[l * 64 + (col & 63)];
    else if (type == 1) g = p.kn_a[l * 64 + (col & 63)];
    else if (type == 4) g = p.qn_b[l * 32 + (col & 31)];
    else if (type == 5) g = p.kn_b[l * 32 + (col & 31)];
    X[256 + col] = g;
  }
  f32x16 acc[2][2];
  gemm_core<2>(HP + (size_t)m0 * LDP, LDP, WT + (size_t)n0 * LDP, LDP, 1024, acc, lds);

  float sw[2][16];
#pragma unroll
  for (int tn = 0; tn < 2; ++tn)
#pragma unroll
    for (int q = 0; q < 4; ++q) { const float4 s4 = *(const float4*)(X + 128 + wn * 64 + tn * 32 + q * 8 + h * 4); sw[tn][q * 4 + 0] = s4.x; sw[tn][q * 4 + 1] = s4.y; sw[tn][q * 4 + 2] = s4.z; sw[tn][q * 4 + 3] = s4.w; }

  bf16_t* E = (bf16_t*)lds;
  const float* ropeA = (const float*)(p.ws + OFF_ROPEA);
  const float* ropeB = (const float*)(p.ws + OFF_ROPEB);

#pragma unroll
  for (int tm = 0; tm < 2; ++tm) {
    const int trow = wm * 64 + tm * 32 + lr;
    const int tok = m0 + trow;
    const float rstd = X[trow];
    float v[2][16];
#pragma unroll
    for (int tn = 0; tn < 2; ++tn)
#pragma unroll
      for (int i = 0; i < 16; ++i) v[tn][i] = rstd * acc[tn][tm][i] + sw[tn][i];

    int s, bq, Lk, krow; size_t vbA, vbB, pqb; int S;
    if (!lat) { bq = tok >> 8; s = tok & 255; Lk = 256; krow = tok; vbA = (size_t)bq * 32768; vbB = (size_t)bq * 65536; pqb = (size_t)bq * 131072; S = 256; }
    else { bq = jb; s = (tok - NCTX) & 1023; Lk = 1536; krow = NCTX + jb * 1536 + s; vbA = 1048576 + (size_t)jb * 196608; vbB = 2097152 + (size_t)jb * 393216; pqb = 32ull * 131072 + (size_t)jb * 524288; S = 1024; }

    if (type == 3) {
      bf16_t* G = E + trow * 136 + wn * 64 + h * 4;
#pragma unroll
      for (int tn = 0; tn < 2; ++tn)
#pragma unroll
        for (int q = 0; q < 4; ++q) st_bf4(G + tn * 32 + q * 8, silu(v[tn][q * 4]), silu(v[tn][q * 4 + 1]), silu(v[tn][q * 4 + 2]), silu(v[tn][q * 4 + 3]));
    } else if (type == 0 || type == 1) {
      float ss = 0.f;
#pragma unroll
      for (int tn = 0; tn < 2; ++tn)
#pragma unroll
        for (int i = 0; i < 16; ++i) ss += v[tn][i] * v[tn][i];
      ss += __shfl_xor(ss, 32);
      const float r = rsqrtf(ss * (1.f / 64.f) + EPS);
      const float* gp = X + 256 + wn * 64 + h * 4;
#pragma unroll
      for (int tn = 0; tn < 2; ++tn)
#pragma unroll
        for (int q = 0; q < 4; ++q) { const float4 g4 = *(const float4*)(gp + tn * 32 + q * 8); v[tn][q * 4] *= r * g4.x; v[tn][q * 4 + 1] *= r * g4.y; v[tn][q * 4 + 2] *= r * g4.z; v[tn][q * 4 + 3] *= r * g4.w; }
      if (type == 1 && !lat) {
        const int kvh = wn;
        float* o = p.out + 12582912ull + ((((size_t)(bq * 2 + l) * 256 + s) * 2 + 0) * 2 + kvh) * 64 + h * 4;
#pragma unroll
        for (int tn = 0; tn < 2; ++tn)
#pragma unroll
          for (int q = 0; q < 4; ++q) *(float4*)(o + tn * 32 + q * 8) = make_float4(v[tn][q * 4], v[tn][q * 4 + 1], v[tn][q * 4 + 2], v[tn][q * 4 + 3]);
      }
      if (lat) {
        const float* cp = ropeA + (size_t)s * 32 + h * 4;
        const float* sp = cp + 1024 * 32;
#pragma unroll
        for (int tn = 0; tn < 2; ++tn)
#pragma unroll
          for (int q = 0; q < 2; ++q) {
            const float4 c4 = *(const float4*)(cp + tn * 16 + q * 8), s4 = *(const float4*)(sp + tn * 16 + q * 8);
            const float cc[4] = {c4.x, c4.y, c4.z, c4.w}, sn[4] = {s4.x, s4.y, s4.z, s4.w};
#pragma unroll
            for (int e = 0; e < 4; ++e) { const float x1 = v[tn][q * 4 + e], x2 = v[tn][(q + 2) * 4 + e]; v[tn][q * 4 + e] = x1 * cc[e] - x2 * sn[e]; v[tn][(q + 2) * 4 + e] = x1 * sn[e] + x2 * cc[e]; }
          }
      }
      if (type == 0) {
        const float sc = 0.125f * LOG2E;
        bf16_t* Q = E + trow * 136 + wn * 64 + h * 4;
#pragma unroll
        for (int tn = 0; tn < 2; ++tn)
#pragma unroll
          for (int q = 0; q < 4; ++q) st_bf4(Q + tn * 32 + q * 8, v[tn][q * 4] * sc, v[tn][q * 4 + 1] * sc, v[tn][q * 4 + 2] * sc, v[tn][q * 4 + 3] * sc);
      } else {
        bf16_t* Kp = E + trow * 136 + wn * 64 + h * 4;
#pragma unroll
        for (int tn = 0; tn < 2; ++tn)
#pragma unroll
          for (int q = 0; q < 4; ++q) st_bf4(Kp + tn * 32 + q * 8, v[tn][q * 4], v[tn][q * 4 + 1], v[tn][q * 4 + 2], v[tn][q * 4 + 3]);
      }
    } else if (type == 2) {
      const int kvh = wn;
      if (!lat) {
        float* o = p.out + 12582912ull + ((((size_t)(bq * 2 + l) * 256 + s) * 2 + 1) * 2 + kvh) * 64 + h * 4;
#pragma unroll
        for (int tn = 0; tn < 2; ++tn)
#pragma unroll
          for (int q = 0; q < 4; ++q) *(float4*)(o + tn * 32 + q * 8) = make_float4(v[tn][q * 4], v[tn][q * 4 + 1], v[tn][q * 4 + 2], v[tn][q * 4 + 3]);
      }
      bf16_t* Vt = E + (wn * 64 + h * 4) * 136 + trow;
#pragma unroll
      for (int tn = 0; tn < 2; ++tn)
#pragma unroll
        for (int i = 0; i < 16; ++i) Vt[(tn * 32 + (i >> 2) * 8 + (i & 3)) * 136] = f2bf(v[tn][i]);
    } else if (type == 4 || type == 5) {
      const int hb = (nb - (type == 4 ? 1280 : 1536)) >> 6;
      const float* gp = X + 256 + wn * 64 + h * 4;
#pragma unroll
      for (int tn = 0; tn < 2; ++tn) {
        float ss = 0.f;
#pragma unroll
        for (int i = 0; i < 16; ++i) ss += v[tn][i] * v[tn][i];
        ss += __shfl_xor(ss, 32);
        const float r = rsqrtf(ss * (1.f / 32.f) + EPS);
#pragma unroll
        for (int q = 0; q < 4; ++q) { const float4 g4 = *(const float4*)(gp + q * 8); v[tn][q * 4] *= r * g4.x; v[tn][q * 4 + 1] *= r * g4.y; v[tn][q * 4 + 2] *= r * g4.z; v[tn][q * 4 + 3] *= r * g4.w; }
      }
      if (type == 5 && !lat) {
        float* o = p.out + 16777216ull + ((((size_t)(bq * 2 + l) * 256 + s) * 2 + 0) * 4 + hb) * 64 + h * 4;
#pragma unroll
        for (int tn = 0; tn < 2; ++tn)
#pragma unroll
          for (int q = 0; q < 4; ++q) *(float4*)(o + tn * 32 + q * 8) = make_float4(v[tn][q * 4], v[tn][q * 4 + 1], v[tn][q * 4 + 2], v[tn][q * 4 + 3]);
      }
      if (lat) {
        const float* cp = ropeB + (size_t)s * 16 + h * 4;
        const float* sp = cp + 1024 * 16;
#pragma unroll
        for (int hf = 0; hf < 2; ++hf) {
          const float4 c4 = *(const float4*)(cp + hf * 8), s4 = *(const float4*)(sp + hf * 8);
          const float cc[4] = {c4.x, c4.y, c4.z, c4.w}, sn[4] = {s4.x, s4.y, s4.z, s4.w};
#pragma unroll
          for (int tn = 0; tn < 2; ++tn)
#pragma unroll
            for (int e = 0; e < 4; ++e) { const float x1 = v[tn][(2 * hf) * 4 + e], x2 = v[tn][(2 * hf + 1) * 4 + e]; v[tn][(2 * hf) * 4 + e] = x1 * cc[e] - x2 * sn[e]; v[tn][(2 * hf + 1) * 4 + e] = x1 * sn[e] + x2 * cc[e]; }
        }
      }
      if (type == 4) {
        const float sc = 0.17677669529663687f * LOG2E;
        bf16_t* Q = E + trow * 136 + wn * 64 + h * 4;
#pragma unroll
        for (int tn = 0; tn < 2; ++tn)
#pragma unroll
          for (int q = 0; q < 4; ++q) st_bf4(Q + tn * 32 + q * 8, v[tn][q * 4] * sc, v[tn][q * 4 + 1] * sc, v[tn][q * 4 + 2] * sc, v[tn][q * 4 + 3] * sc);
      } else {
        bf16_t* Kp = E + trow * 136 + wn * 64 + h * 4;
#pragma unroll
        for (int tn = 0; tn < 2; ++tn)
#pragma unroll
          for (int q = 0; q < 4; ++q) st_bf4(Kp + tn * 32 + q * 8, v[tn][q * 4], v[tn][q * 4 + 1], v[tn][q * 4 + 2], v[tn][q * 4 + 3]);
      }
    } else if (type == 6) {
      const int hb = (nb - 1792) >> 6;
      if (!lat) {
        float* o = p.out + 16777216ull + ((((size_t)(bq * 2 + l) * 256 + s) * 2 + 1) * 4 + hb) * 64 + h * 4;
#pragma unroll
        for (int tn = 0; tn < 2; ++tn)
#pragma unroll
          for (int q = 0; q < 4; ++q) *(float4*)(o + tn * 32 + q * 8) = make_float4(v[tn][q * 4], v[tn][q * 4 + 1], v[tn][q * 4 + 2], v[tn][q * 4 + 3]);
      }
      bf16_t* Vt = E + (wn * 64 + h * 4) * 136 + trow;
#pragma unroll
      for (int tn = 0; tn < 2; ++tn)
#pragma unroll
        for (int i = 0; i < 16; ++i) Vt[(tn * 32 + (i >> 2) * 8 + (i & 3)) * 136] = f2bf(v[tn][i]);
    } else {
      bf16_t* PQ = E + (wn * 64 + h * 4) * 136 + trow;
#pragma unroll
      for (int tn = 0; tn < 2; ++tn)
#pragma unroll
        for (int i = 0; i < 16; ++i) PQ[(tn * 32 + (i >> 2) * 8 + (i & 3)) * 136] = f2bf(v[tn][i]);
    }
  }
  __syncthreads();
  {
    const int s0 = lat ? ((m0 - NCTX) & 1023) : (m0 & 255);
    const int krow0 = lat ? NCTX + jb * 1536 + s0 : m0;
    const int Lk0 = lat ? 1536 : 256, S0 = lat ? 1024 : 256;
    const int bq0 = lat ? jb : (m0 >> 8);
    bf16_t* dst; size_t stride;
    if (type == 0) { dst = (bf16_t*)(p.ws + OFF_QA) + (size_t)m0 * 512 + n0; stride = 512; }
    else if (type == 1) { dst = (bf16_t*)(p.ws + OFF_KA) + (size_t)l * KA_L + (size_t)krow0 * 128; stride = 128; }
    else if (type == 2) { dst = (bf16_t*)(p.ws + OFF_VTA) + (size_t)l * KA_L + (lat ? 1048576 + (size_t)jb * 196608 : (size_t)bq0 * 32768) + s0; stride = Lk0; }
    else if (type == 3) { const int g0 = n0 < 1280 ? n0 - 768 : (n0 < 2304 ? 512 + n0 - 2048 : 768 + n0 - 2816); dst = (bf16_t*)(p.ws + OFF_G) + (size_t)m0 * 1024 + g0; stride = 1024; }
    else if (type == 4) { dst = (bf16_t*)(p.ws + OFF_QB) + (size_t)m0 * 256 + (n0 - 1280); stride = 256; }
    else if (type == 5) { dst = (bf16_t*)(p.ws + OFF_KB) + (size_t)l * KB_L + (size_t)krow0 * 256 + (n0 - 1536); stride = 256; }
    else if (type == 6) { dst = (bf16_t*)(p.ws + OFF_VTB) + (size_t)l * KB_L + (lat ? 2097152 + (size_t)jb * 393216 : (size_t)bq0 * 65536) + (size_t)(n0 - 1792) * Lk0 + s0; stride = Lk0; }
    else { const int nn0 = n0 - 2304; dst = (bf16_t*)(p.ws + OFF_PQT) + (lat ? 32ull * 131072 + (size_t)jb * 524288 : (size_t)bq0 * 131072) + (size_t)(nn0 & 255) * (2 * S0) + (nn0 >> 8) * S0 + s0; stride = 2 * S0; }
    const int c = t & 15, r0 = t >> 4;
#pragma unroll
    for (int i = 0; i < 8; ++i) { const int r = r0 + 16 * i; *(uint4*)(dst + (size_t)r * stride + c * 8) = *(const uint4*)(E + r * 136 + c * 8); }
  }
  __syncthreads();
}

DEVI void g2_tile(const Params& p, int l, int mt, int nt, char* lds) {
  const int m0 = mt * 128, n0 = nt * 128;
  const bf16_t* MIX = (const bf16_t*)(p.ws + OFF_MIX);
  const bf16_t* WT = (const bf16_t*)(p.ws + OFF_WTOUT) + (size_t)l * 1024 * LDP;
  f32x16 acc[2][2];
  gemm_core<2>(MIX + (size_t)m0 * LDP, LDP, WT + (size_t)n0 * LDP, LDP, 1024, acc, lds);

  const int t = tid(), lane = t & 63, wave = t >> 6, wm = wave >> 1, wn = wave & 1, lr = lane & 31, h = lane >> 5;
  float* E = (float*)lds;
#pragma unroll
  for (int tm = 0; tm < 2; ++tm)
#pragma unroll
    for (int tn = 0; tn < 2; ++tn)
#pragma unroll
      for (int q = 0; q < 4; ++q)
        *(float4*)(E + (wm * 64 + tm * 32 + lr) * 132 + wn * 64 + tn * 32 + q * 8 + h * 4) =
            make_float4(acc[tn][tm][q * 4], acc[tn][tm][q * 4 + 1], acc[tn][tm][q * 4 + 2], acc[tn][tm][q * 4 + 3]);
  __syncthreads();
  const bool lat = m0 >= NCTX;
  const int cond = lat ? 1 + ((m0 - NCTX) >> 10) : 0;
  const float* MOD = (const float*)(p.ws + OFF_MOD);
  const int c4 = (t & 31) * 4, rb = t >> 5;
  const float4 g4 = *(const float4*)(MOD + (size_t)(l * 5 + cond) * 3072 + 2048 + n0 + c4);
  float4 gs = make_float4(0.f, 0.f, 0.f, 0.f);
  if (l == 0) {
    const float4 ng = *(const float4*)(p.norm_g + 1024 + n0 + c4);
    const float4 sc = *(const float4*)(MOD + (size_t)(5 + cond) * 3072 + 1024 + n0 + c4);
    gs = make_float4(ng.x * (1.f + sc.x), ng.y * (1.f + sc.y), ng.z * (1.f + sc.z), ng.w * (1.f + sc.w));
  }
  const float* xa = opq(p.x_prompt); const float* xb = opq(p.x_sample);
  const float* xin = (lat ? xb + (size_t)(m0 - NCTX) * 1024 : xa + (size_t)m0 * 1024) + n0 + c4;
  bf16_t* y1p = (bf16_t*)(p.ws + OFF_Y1) + (size_t)m0 * 1024 + n0 + c4;
  float* yout = p.out + (size_t)m0 * 1024 + n0 + c4;
  float4 xv[16];
  if (l == 0) {
#pragma unroll
    for (int i = 0; i < 16; ++i) xv[i] = *(const float4*)(xin + (size_t)(rb + 8 * i) * 1024);
  } else {
    uint2 xu[16];
#pragma unroll
    for (int i = 0; i < 16; ++i) xu[i] = *(const uint2*)(y1p + (size_t)(rb + 8 * i) * 1024);
#pragma unroll
    for (int i = 0; i < 16; ++i) xv[i] = make_float4(__uint_as_float(xu[i].x << 16), __uint_as_float(xu[i].x & 0xffff0000u), __uint_as_float(xu[i].y << 16), __uint_as_float(xu[i].y & 0xffff0000u));
  }
#pragma unroll
  for (int i = 0; i < 16; ++i) {
    const int r = rb + 8 * i;
    const float4 a4 = *(const float4*)(E + r * 132 + c4);
    float4 y;
    y.x = xv[i].x + g4.x * a4.x; y.y = xv[i].y + g4.y * a4.y; y.z = xv[i].z + g4.z * a4.z; y.w = xv[i].w + g4.w * a4.w;
    if (l != 0) *(float4*)(yout + (size_t)r * 1024) = y;
    if (l == 0) {
      st_bf4(y1p + (size_t)r * 1024, y.x, y.y, y.z, y.w);
      st_bf4((bf16_t*)(p.ws + OFF_HP) + (size_t)(m0 + r) * LDP + n0 + c4, y.x * gs.x, y.y * gs.y, y.z * gs.z, y.w * gs.w);
      float ss = y.x * y.x + y.y * y.y + y.z * y.z + y.w * y.w;
#pragma unroll
      for (int o = 16; o > 0; o >>= 1) ss += __shfl_xor(ss, o);
      if ((t & 31) == 0) *(float2*)((float*)(p.ws + OFF_SSQ) + (size_t)(m0 + r) * 16 + nt * 2) = make_float2(ss, 0.f);
    }
  }
  __syncthreads();
}

DEVI void g2_half_tile(const Params& p, int l, int mt, int nth, char* lds) {
  const int m0 = mt * 128, n0 = nth * 64;
  const bf16_t* MIX = (const bf16_t*)(p.ws + OFF_MIX);
  const bf16_t* WT = (const bf16_t*)(p.ws + OFF_WTOUT) + (size_t)l * 1024 * LDP;
  f32x16 acc[1][2];
  gemm_core<1>(MIX + (size_t)m0 * LDP, LDP, WT + (size_t)n0 * LDP, LDP, 1024, acc, lds);

  const int t = tid(), lane = t & 63, wave = t >> 6, wm = wave >> 1, wn = wave & 1, lr = lane & 31, h = lane >> 5;
  float* E = (float*)lds;
#pragma unroll
  for (int tm = 0; tm < 2; ++tm)
#pragma unroll
    for (int q = 0; q < 4; ++q)
      *(float4*)(E + (wm * 64 + tm * 32 + lr) * 68 + wn * 32 + q * 8 + h * 4) =
          make_float4(acc[0][tm][q * 4], acc[0][tm][q * 4 + 1], acc[0][tm][q * 4 + 2], acc[0][tm][q * 4 + 3]);
  __syncthreads();
  const bool lat = m0 >= NCTX;
  const int cond = lat ? 1 + ((m0 - NCTX) >> 10) : 0;
  const float* MOD = (const float*)(p.ws + OFF_MOD);
  const int c4 = (t & 15) * 4, rb = t >> 4;
  const float4 g4 = *(const float4*)(MOD + (size_t)(l * 5 + cond) * 3072 + 2048 + n0 + c4);
  float4 gs = make_float4(0.f, 0.f, 0.f, 0.f);
  if (l == 0) {
    const float4 ng = *(const float4*)(p.norm_g + 1024 + n0 + c4);
    const float4 sc = *(const float4*)(MOD + (size_t)(5 + cond) * 3072 + 1024 + n0 + c4);
    gs = make_float4(ng.x * (1.f + sc.x), ng.y * (1.f + sc.y), ng.z * (1.f + sc.z), ng.w * (1.f + sc.w));
  }
  const float* xa = opq(p.x_prompt); const float* xb = opq(p.x_sample);
  const float* xin = (lat ? xb + (size_t)(m0 - NCTX) * 1024 : xa + (size_t)m0 * 1024) + n0 + c4;
  bf16_t* y1p = (bf16_t*)(p.ws + OFF_Y1) + (size_t)m0 * 1024 + n0 + c4;
  float* yout = p.out + (size_t)m0 * 1024 + n0 + c4;
  float4 xv[8];
  if (l == 0) {
#pragma unroll
    for (int i = 0; i < 8; ++i) xv[i] = *(const float4*)(xin + (size_t)(rb + 16 * i) * 1024);
  } else {
    uint2 xu[8];
#pragma unroll
    for (int i = 0; i < 8; ++i) xu[i] = *(const uint2*)(y1p + (size_t)(rb + 16 * i) * 1024);
#pragma unroll
    for (int i = 0; i < 8; ++i) xv[i] = make_float4(__uint_as_float(xu[i].x << 16), __uint_as_float(xu[i].x & 0xffff0000u), __uint_as_float(xu[i].y << 16), __uint_as_float(xu[i].y & 0xffff0000u));
  }
#pragma unroll
  for (int i = 0; i < 8; ++i) {
    const int r = rb + 16 * i;
    const float4 a4 = *(const float4*)(E + r * 68 + c4);
    float4 y;
    y.x = xv[i].x + g4.x * a4.x; y.y = xv[i].y + g4.y * a4.y; y.z = xv[i].z + g4.z * a4.z; y.w = xv[i].w + g4.w * a4.w;
    if (l != 0) *(float4*)(yout + (size_t)r * 1024) = y;
    if (l == 0) {
      st_bf4(y1p + (size_t)r * 1024, y.x, y.y, y.z, y.w);
      st_bf4((bf16_t*)(p.ws + OFF_HP) + (size_t)(m0 + r) * LDP + n0 + c4, y.x * gs.x, y.y * gs.y, y.z * gs.z, y.w * gs.w);
      float ss = y.x * y.x + y.y * y.y + y.z * y.z + y.w * y.w;
#pragma unroll
      for (int o = 8; o > 0; o >>= 1) ss += __shfl_xor(ss, o);
      if ((t & 15) == 0) ((float*)(p.ws + OFF_SSQ))[(size_t)(m0 + r) * 16 + nth] = ss;
    }
  }
  __syncthreads();
}

DEVI void attn_rows_out(const Params& p, const float* Ot, int tokbase, int colbase, const float* gain, int lane);
DEVI void fourier_tile(const Params& p, int tok_seq0, int S, size_t pqb, int mt, int nt, char* lds) {
  const bf16_t* T = (const bf16_t*)(p.ws + (S == 256 ? OFF_T256 : OFF_T1024));
  const bf16_t* PQ = (const bf16_t*)(p.ws + OFF_PQT) + pqb;
  f32x16 acc[2][2];
  gemm_core<2>(T + (size_t)(mt * 128) * (2 * S), 2 * S, PQ + (size_t)(nt * 128) * (2 * S), 2 * S, 2 * S, acc, lds);
  const int t = tid(), lane = t & 63, wave = t >> 6, wm = wave >> 1, wn = wave & 1, lr = lane & 31, h = lane >> 5;
  float* Ot = (float*)lds + wave * (64 * 68);
#pragma unroll
  for (int tm = 0; tm < 2; ++tm)
#pragma unroll
    for (int tn = 0; tn < 2; ++tn)
#pragma unroll
      for (int q = 0; q < 4; ++q)
        *(float4*)(Ot + (tm * 32 + lr) * 68 + tn * 32 + q * 8 + h * 4) = make_float4(acc[tn][tm][q * 4], acc[tn][tm][q * 4 + 1], acc[tn][tm][q * 4 + 2], acc[tn][tm][q * 4 + 3]);
  const int tokb = tok_seq0 + mt * 128 + wm * 64, colb = 768 + nt * 128 + wn * 64;
  attn_rows_out(p, Ot, tokb, colb, nullptr, lane);
  attn_rows_out(p, Ot + 32 * 68, tokb + 32, colb, nullptr, lane);
}

DEVI void attn_rows_out(const Params& p, const float* Ot, int tokbase, int colbase, const float* gain, int lane) {
  const int rr = lane >> 3, ch = lane & 7;
  const bf16_t* Gb = (const bf16_t*)(p.ws + OFF_G) + (size_t)tokbase * 1024 + colbase + ch * 8;
  bf16_t* Mb = (bf16_t*)(p.ws + OFF_MIX) + (size_t)tokbase * LDP + colbase + ch * 8;
  uint4 g8[4];
#pragma unroll
  for (int i = 0; i < 4; ++i) g8[i] = *(const uint4*)(Gb + (size_t)(rr + 8 * i) * 1024);
  float4 s0 = make_float4(1.f, 1.f, 1.f, 1.f), s1 = s0;
  if (gain) { s0 = *(const float4*)(gain + ch * 8); s1 = *(const float4*)(gain + ch * 8 + 4); }
#pragma unroll
  for (int i = 0; i < 4; ++i) {
    const int row = rr + 8 * i;
    const float4 a = *(const float4*)(Ot + row * 68 + ch * 8), b = *(const float4*)(Ot + row * 68 + ch * 8 + 4);
    const uint4 g = g8[i];
    uint4 o;
    o.x = pk_bf16(a.x * s0.x * __uint_as_float(g.x << 16), a.y * s0.y * __uint_as_float(g.x & 0xffff0000u));
    o.y = pk_bf16(a.z * s0.z * __uint_as_float(g.y << 16), a.w * s0.w * __uint_as_float(g.y & 0xffff0000u));
    o.z = pk_bf16(b.x * s1.x * __uint_as_float(g.z << 16), b.y * s1.y * __uint_as_float(g.z & 0xffff0000u));
    o.w = pk_bf16(b.z * s1.z * __uint_as_float(g.w << 16), b.w * s1.w * __uint_as_float(g.w & 0xffff0000u));
    *(uint4*)(Mb + (size_t)row * LDP) = o;
  }
}

template <int NC>
DEVI void attn_unit(const Params& p, int l, int tok0, int head, char* lds) {
  const int t = tid(), lane = t & 63, wave = t >> 6, lr = lane & 31, h = lane >> 5;
  constexpr int KS = 4 / NC;
  const int comp = (NC == 1) ? 0 : (wave >> 1);
  const int qrow = (NC == 1) ? wave * 32 : (wave & 1) * 32;
  const bool lat = tok0 >= NCTX;
  int Lk, krow0; size_t vbase;
  if (!lat) { const int b = tok0 >> 8; Lk = 256; krow0 = b * 256; vbase = (NC == 1) ? (size_t)b * 32768 : (size_t)b * 65536; }
  else { const int j = (tok0 - NCTX) >> 10; Lk = 1536; krow0 = NCTX + j * 1536; vbase = (NC == 1) ? 1048576 + (size_t)j * 196608 : 2097152 + (size_t)j * 393216; }
  const bf16_t *Kg, *Vg, *Qg; int kst, qst;
  if (NC == 1) {
    const int kvh = head >> 2;
    Kg = (const bf16_t*)(p.ws + OFF_KA) + (size_t)l * KA_L + (size_t)krow0 * 128 + kvh * 64; kst = 128;
    Vg = (const bf16_t*)(p.ws + OFF_VTA) + (size_t)l * KA_L + vbase + (size_t)kvh * 64 * Lk;
    Qg = (const bf16_t*)(p.ws + OFF_QA) + (size_t)tok0 * 512 + head * 64; qst = 512;
  } else {
    Kg = (const bf16_t*)(p.ws + OFF_KB) + (size_t)l * KB_L + (size_t)krow0 * 256 + head * 64; kst = 256;
    Vg = (const bf16_t*)(p.ws + OFF_VTB) + (size_t)l * KB_L + vbase + (size_t)head * 64 * Lk;
    Qg = (const bf16_t*)(p.ws + OFF_QB) + (size_t)tok0 * 256 + head * 64; qst = 256;
  }
  bf16x8 qf[KS];
  {
    const bf16_t* qp = Qg + (size_t)(qrow + lr) * qst + comp * 32 + h * 8;
#pragma unroll
    for (int j = 0; j < KS; ++j) qf[j] = *(const bf16x8*)(qp + j * 16);
  }
  float Mb;
  {
    constexpr int DQ = 64 / NC;
    const float* gqp = (NC == 1) ? p.qn_a : p.qn_b;
    const float* gkp = (NC == 1) ? p.kn_a : p.kn_b;
    float gq = fabsf(gqp[l * DQ + (lane & (DQ - 1))]), gk = fabsf(gkp[l * DQ + (lane & (DQ - 1))]);
#pragma unroll
    for (int o = 32; o > 0; o >>= 1) { gq = fmaxf(gq, __shfl_xor(gq, o)); gk = fmaxf(gk, __shfl_xor(gk, o)); }
    const float qn = sqrtf((float)DQ) * gq;
    float kn = sqrtf((float)DQ) * gk;
    if (lat) kn = fmaxf(kn, sqrtf(((const float*)(p.ws + OFF_KMAX))[l * 2 + NC - 1]));
    Mb = qn * kn * ((NC == 1) ? 0.125f : 0.17677669529663687f) * LOG2E * 1.02f;
  }
  const bool fast = Mb < 56.f;
  f32x16 O[2];
  float mrun = -INFINITY, lsum = 0.f;
#pragma unroll
  for (int dt = 0; dt < 2; ++dt)
#pragma unroll
    for (int i = 0; i < 16; ++i) O[dt][i] = 0.f;
  const int c8 = t & 7, r0 = t >> 3;
  uint4 rk0, rk1, rv0, rv1;
  uint4 sk0, sk1, sv0, sv1;
  const bf16_t* kp = Kg + (size_t)r0 * kst + c8 * 8;
  const bf16_t* vp = Vg + (size_t)r0 * Lk + c8 * 8;
  const int nkt = Lk >> 6;
#define ALOAD0(KT) { rk0 = *(const uint4*)(kp + (size_t)((KT) * 64) * kst); rk1 = *(const uint4*)(kp + (size_t)((KT) * 64 + 32) * kst); \
                     rv0 = *(const uint4*)(vp + (KT) * 64); rv1 = *(const uint4*)(vp + (size_t)32 * Lk + (KT) * 64); }
#define ALOAD1(KT) { sk0 = *(const uint4*)(kp + (size_t)((KT) * 64) * kst); sk1 = *(const uint4*)(kp + (size_t)((KT) * 64 + 32) * kst); \
                     sv0 = *(const uint4*)(vp + (KT) * 64); sv1 = *(const uint4*)(vp + (size_t)32 * Lk + (KT) * 64); }
#define AWRITE0(W) { *(uint4*)(W) = rk0; *(uint4*)((W) + 32 * 144) = rk1; *(uint4*)((W) + 9216) = rv0; *(uint4*)((W) + 9216 + 32 * 144) = rv1; }
#define AWRITE1(W) { *(uint4*)(W) = sk0; *(uint4*)((W) + 32 * 144) = sk1; *(uint4*)((W) + 9216) = sv0; *(uint4*)((W) + 9216 + 32 * 144) = sv1; }
  auto tile = [&](const char* base) {
    const char* sK = base + comp * 64;
    const char* sV = base + 9216;
#pragma unroll
    for (int kk = 0; kk < 2; ++kk) {
      asm volatile("" ::: "memory");
      bf16x8 pf[2];
      f32x16 S;
      const float sinit = fast ? -Mb : 0.f;
#pragma unroll
      for (int i = 0; i < 16; ++i) S[i] = sinit;
#pragma unroll
      for (int j = 0; j < KS; ++j) {
        const bf16x8 kf = *(const bf16x8*)(sK + ((kk * 32 + lr) * 72 + j * 16 + h * 8) * 2);
        S = mfma32(kf, qf[j], S);
      }
      if (fast) {
        float ps = 0.f;
#pragma unroll
        for (int i = 0; i < 16; ++i) { S[i] = __builtin_amdgcn_exp2f(S[i]); ps += S[i]; }
        lsum += ps;
      } else {
        float mx = S[0];
#pragma unroll
        for (int i = 1; i < 16; ++i) mx = fmaxf(mx, S[i]);
        mx = fmaxf(mx, __shfl_xor(mx, 32));
        const float mnew = fmaxf(mrun, mx);
        const float alpha = __builtin_amdgcn_exp2f(mrun - mnew);
        mrun = mnew;
        float ps = 0.f;
#pragma unroll
        for (int i = 0; i < 16; ++i) { S[i] = __builtin_amdgcn_exp2f(S[i] - mnew); ps += S[i]; }
        lsum = lsum * alpha + ps;
#pragma unroll
        for (int dt = 0; dt < 2; ++dt)
#pragma unroll
          for (int i = 0; i < 16; ++i) O[dt][i] *= alpha;
      }
#pragma unroll
      for (int s2 = 0; s2 < 2; ++s2) {
        u32x4 u;
        u.x = pk_bf16(S[8 * s2 + 0], S[8 * s2 + 1]); u.y = pk_bf16(S[8 * s2 + 2], S[8 * s2 + 3]);
        u.z = pk_bf16(S[8 * s2 + 4], S[8 * s2 + 5]); u.w = pk_bf16(S[8 * s2 + 6], S[8 * s2 + 7]);
        pf[s2] = __builtin_bit_cast(bf16x8, u);
      }
#pragma unroll
      for (int dt = 0; dt < 2; ++dt)
#pragma unroll
        for (int s2 = 0; s2 < 2; ++s2) {
          const char* va = sV + ((dt * 32 + lr) * 72 + kk * 32 + 16 * s2 + 4 * h) * 2;
          const uint2 v0 = *(const uint2*)va, v1 = *(const uint2*)(va + 16);
          u32x4 u; u.x = v0.x; u.y = v0.y; u.z = v1.x; u.w = v1.y;
          O[dt] = mfma32(__builtin_bit_cast(bf16x8, u), pf[s2], O[dt]);
        }
    }
  };
  char* const w0 = lds + (r0 * 72 + c8 * 8) * 2;
  char* const w1 = w0 + 18432;
  ALOAD1(0);
  ALOAD0(1);
  AWRITE1(w0);
  ALOAD1(2);
  __syncthreads();
  for (int kt = 0; kt < nkt - 2; kt += 2) {
    tile(lds);
    AWRITE0(w1);
    { const int kn = (kt + 3 < nkt) ? kt + 3 : nkt - 1; ALOAD0(kn); }
    __syncthreads();
    tile(lds + 18432);
    AWRITE1(w0);
    { const int kn = (kt + 4 < nkt) ? kt + 4 : nkt - 1; ALOAD1(kn); }
    __syncthreads();
  }
  tile(lds);
  AWRITE0(w1);
  __syncthreads();
  tile(lds + 18432);
  __syncthreads();
#undef ALOAD0
#undef ALOAD1
#undef AWRITE0
#undef AWRITE1
  const int tok = tok0 + qrow + lr;
  const float inv = 1.f / (lsum + __shfl_xor(lsum, 32));
  if (NC == 1) {
    float* Ot = (float*)lds + wave * (32 * 68);
#pragma unroll
    for (int dt = 0; dt < 2; ++dt)
#pragma unroll
      for (int q = 0; q < 4; ++q)
        *(float4*)(Ot + lr * 68 + dt * 32 + q * 8 + h * 4) = make_float4(O[dt][q * 4] * inv, O[dt][q * 4 + 1] * inv, O[dt][q * 4 + 2] * inv, O[dt][q * 4 + 3] * inv);
    attn_rows_out(p, Ot, tok0 + qrow, head * 64, nullptr, lane);
  } else {
    float* ex = (float*)lds + (size_t)(wave & 1) * 2048 + lane;
    if (comp == 1) {
#pragma unroll
      for (int dt = 0; dt < 2; ++dt)
#pragma unroll
        for (int i = 0; i < 16; ++i) ex[(dt * 16 + i) * 64] = O[dt][i] * inv;
    }
    __syncthreads();
    if (comp == 0) {
      float d1 = p.lq1[l * 32 + lr] * p.lk1[l * 32 + lr], d2 = p.lq2[l * 32 + lr] * p.lk2[l * 32 + lr];
#pragma unroll
      for (int o = 16; o > 0; o >>= 1) { d1 += __shfl_xor(d1, o); d2 += __shfl_xor(d2, o); }
      const float lam_init = (l == 0) ? 0.2f : 0.35550907f;
      const float lam = expf(d1) - expf(d2) + lam_init;
      float ss = 0.f;
#pragma unroll
      for (int dt = 0; dt < 2; ++dt)
#pragma unroll
        for (int i = 0; i < 16; ++i) { O[dt][i] = O[dt][i] * inv - lam * ex[(dt * 16 + i) * 64]; ss += O[dt][i] * O[dt][i]; }
      ss += __shfl_xor(ss, 32);
      const float r = rsqrtf(ss * (1.f / 64.f) + EPS) * (1.f - lam_init);
      float* Ot = (float*)(lds + 16384) + (wave & 1) * (32 * 68);
#pragma unroll
      for (int dt = 0; dt < 2; ++dt)
#pragma unroll
        for (int q = 0; q < 4; ++q)
          *(float4*)(Ot + lr * 68 + dt * 32 + q * 8 + h * 4) = make_float4(O[dt][q * 4] * r, O[dt][q * 4 + 1] * r, O[dt][q * 4 + 2] * r, O[dt][q * 4 + 3] * r);
      attn_rows_out(p, Ot, tok0 + qrow, 512 + head * 64, p.subln_g + l * 64, lane);
    }
    __syncthreads();
  }
}

DEVI void att_phase_unit(const Params& p, int l, int u, char* lds) {
  if (u < 64) { const int j = u >> 4, mt = (u >> 1) & 7, nt = u & 1; fourier_tile(p, NCTX + j * 1024, 1024, 32ull * 131072 + (size_t)j * 524288, mt, nt, lds); return; }
  u -= 64;
  if (u < 256) { const int j = u >> 6, head = (u >> 3) & 7, qb = u & 7; attn_unit<1>(p, l, NCTX + j * 1024 + qb * 128, head, lds); return; }
  u -= 256;
  if (u < 256) { const int j = u >> 6, head = (u >> 4) & 3, qb = u & 15; attn_unit<2>(p, l, NCTX + j * 1024 + qb * 64, head, lds); return; }
  u -= 256;
  if (u < 128) { const int b = u >> 2, mt = (u >> 1) & 1, nt = u & 1; fourier_tile(p, b * 256, 256, (size_t)b * 131072, mt, nt, lds); return; }
  u -= 128;
  if (u < 512) { const int b = u >> 4, head = (u >> 1) & 7, qb = u & 1; attn_unit<1>(p, l, b * 256 + qb * 128, head, lds); return; }
  u -= 512;
  { const int b = u >> 4, head = (u >> 2) & 3, qb = u & 3; attn_unit<2>(p, l, b * 256 + qb * 64, head, lds); }
}
constexpr int ATT_UNITS = 256 + 256 + 64 + 512 + 512 + 128;

DEVI void p0a(const Params& p, char* lds) {
  const int t = tid(), nb = gridDim.x, bid = blockIdx.x;
  float* lf = (float*)lds;
  {
    float* sl = lf;
    float* red = lf + 5120;
    bool loaded = false;
    for (int it = bid; it < 384; it += nb) {
      if (!loaded) {
        const float* ca = opq(p.c_ctx); const float* cb = opq(p.c);
        for (int cnd = 0; cnd < 5; ++cnd) {
          const float4 v = *(const float4*)((cnd == 0 ? ca : cb + (cnd - 1) * 1024) + t * 4);
          *(float4*)(sl + cnd * 1024 + t * 4) = make_float4(v.x / (1.f + expf(-v.x)), v.y / (1.f + expf(-v.y)), v.z / (1.f + expf(-v.z)), v.w / (1.f + expf(-v.w)));
        }
        loaded = true;
        __syncthreads();
      }
      const int l = it / 192, cb16 = it % 192, c4 = t & 3, kg = t >> 2;
      const float* wp = p.w_mod + (size_t)l * 1024 * 3072 + cb16 * 16 + c4 * 4 + (size_t)kg * 3072;
      float4 w[16];
#pragma unroll
      for (int i = 0; i < 16; ++i) w[i] = *(const float4*)(wp + (size_t)(64 * i) * 3072);
      float a[5][4];
#pragma unroll
      for (int cnd = 0; cnd < 5; ++cnd)
#pragma unroll
        for (int e = 0; e < 4; ++e) a[cnd][e] = 0.f;
#pragma unroll
      for (int i = 0; i < 16; ++i)
#pragma unroll
        for (int cnd = 0; cnd < 5; ++cnd) { const float sv = sl[cnd * 1024 + kg + 64 * i]; a[cnd][0] += sv * w[i].x; a[cnd][1] += sv * w[i].y; a[cnd][2] += sv * w[i].z; a[cnd][3] += sv * w[i].w; }
#pragma unroll
      for (int cnd = 0; cnd < 5; ++cnd)
#pragma unroll
        for (int e = 0; e < 4; ++e) red[(kg * 5 + cnd) * 16 + c4 * 4 + e] = a[cnd][e];
      __syncthreads();
      if (t < 80) {
        const int cnd = t >> 4, col = t & 15;
        float sum = p.b_mod[l * 3072 + cb16 * 16 + col];
        for (int g = 0; g < 64; ++g) sum += red[(g * 5 + cnd) * 16 + col];
        ((float*)(p.ws + OFF_MOD))[(size_t)(l * 5 + cnd) * 3072 + cb16 * 16 + col] = sum;
      }
      __syncthreads();
    }
    __syncthreads();
  }
  for (int it = bid; it < 1280 + 512 + 384; it += nb) {
    const float* src; bf16_t* dst; int ld, ldd;
    if (it < 1280) {
      const int l = it / 640, r = it % 640, nt = r >> 4, kt = r & 15;
      const int sn0 = nt < 36 ? nt * 64 : 2560 + (nt - 36) * 64, dn0 = nt < 36 ? nt * 64 : 2816 + (nt - 36) * 64;
      src = p.w_in + (size_t)l * 1024 * 2816 + (size_t)(kt * 64) * 2816 + sn0; ld = 2816; ldd = LDP;
      dst = (bf16_t*)(p.ws + OFF_WTIN) + (size_t)l * 3072 * LDP + (size_t)dn0 * LDP + kt * 64;
    } else if (it < 1792) {
      const int q = it - 1280, l = q >> 8, r = q & 255, nt = r >> 4, kt = r & 15;
      src = p.w_out + (size_t)l * 1024 * 1024 + (size_t)(kt * 64) * 1024 + nt * 64; ld = 1024; ldd = LDP;
      dst = (bf16_t*)(p.ws + OFF_WTOUT) + (size_t)l * 1024 * LDP + (size_t)(nt * 64) * LDP + kt * 64;
    } else if (it < 1792 + 128) {
      const int q = it - 1792, j = q >> 5, l = (q >> 4) & 1, pt = (q >> 1) & 7, kvh = q & 1;
      src = p.cache_a + ((size_t)((j * 2 + l) * 512 + pt * 64) * 2 + 1) * 128 + kvh * 64; ld = 256; ldd = 1536;
      dst = (bf16_t*)(p.ws + OFF_VTA) + (size_t)l * KA_L + 1048576 + (size_t)j * 196608 + (size_t)(kvh * 64) * 1536 + 1024 + pt * 64;
    } else {
      const int q = it - 1920, j = q >> 6, l = (q >> 5) & 1, pt = (q >> 2) & 7, hh = q & 3;
      src = p.cache_b + ((size_t)((j * 2 + l) * 512 + pt * 64) * 2 + 1) * 256 + hh * 64; ld = 512; ldd = 1536;
      dst = (bf16_t*)(p.ws + OFF_VTB) + (size_t)l * KB_L + 2097152 + (size_t)j * 393216 + (size_t)(hh * 64) * 1536 + 1024 + pt * 64;
    }
    {
      const int col = t & 63, rw = t >> 6;
#pragma unroll
      for (int i = 0; i < 16; ++i) lf[(rw + 4 * i) * 65 + col] = src[(size_t)(rw + 4 * i) * ld + col];
    }
    __syncthreads();
    {
      const int n = t >> 2, kc = (t & 3) * 16;
      uint32_t w[8];
#pragma unroll
      for (int j = 0; j < 8; ++j) w[j] = pk_bf16(lf[(kc + 2 * j) * 65 + n], lf[(kc + 2 * j + 1) * 65 + n]);
      uint4* d = (uint4*)(dst + (size_t)n * ldd + kc);
      d[0] = make_uint4(w[0], w[1], w[2], w[3]); d[1] = make_uint4(w[4], w[5], w[6], w[7]);
    }
    __syncthreads();
  }
  {
    if (t < 64) { lf[t] = cospif((float)t / 32.f); lf[64 + t] = sinpif((float)t / 32.f); }
    __syncthreads();
    for (int gid = bid * NTHREADS + t; gid < 2 * 256 * 512; gid += nb * NTHREADS) {
      const int l = gid >> 17, r = (gid >> 9) & 255, n = gid & 511, comp = n >> 8, nn = n & 255, g = r >> 6, cc = r & 63;
      const float* wc = p.w_c + (size_t)l * 65536 + (size_t)(g * 64) * 256 + nn;
      const float* tb = lf + comp * 64;
      float s = 0.f;
      float wv[64];
#pragma unroll
      for (int c2 = 0; c2 < 64; ++c2) wv[c2] = wc[(size_t)c2 * 256];
#pragma unroll
      for (int c2 = 0; c2 < 64; ++c2) s += tb[(cc * c2) & 63] * wv[c2];
      ((float*)(p.ws + OFF_W12))[gid] = s;
    }
    __syncthreads();
  }
  for (int gid = bid * NTHREADS + t; gid < 256 * 512; gid += nb * NTHREADS) {
    const int sp = gid >> 9, k = gid & 511, kk = k & 255, m = (sp * kk) & 255;
    const float ang = (float)m / 128.f;
    const float v = (k < 256 ? cospif(ang) : -sinpif(ang)) * (1.f / 128.f);
    ((bf16_t*)(p.ws + OFF_T256))[gid] = f2bf(v);
  }
  for (int gid = bid * NTHREADS + t; gid < 1024 * 2048; gid += nb * NTHREADS) {
    const int sp = gid >> 11, k = gid & 2047, kk = k & 1023, m = (sp * kk) & 1023;
    const float ang = (float)m / 512.f;
    const float v = (k < 1024 ? cospif(ang) : -sinpif(ang)) * (1.f / 256.f);
    ((bf16_t*)(p.ws + OFF_T1024))[gid] = f2bf(v);
  }
  for (int gid = bid * NTHREADS + t; gid < 1024 * 32; gid += nb * NTHREADS) {
    const int s = gid >> 5, j = gid & 31, f = j & 15;
    const float pos = (float)(j < 16 ? (s >> 6) : (s & 63));
    const float inv = 1.0f / powf(10000.f, (float)f / 16.f);
    const float ang = pos * inv;
    float* R = (float*)(p.ws + OFF_ROPEA);
    R[gid] = cosf(ang); R[1024 * 32 + gid] = sinf(ang);
  }
  for (int gid = bid * NTHREADS + t; gid < 1024 * 16; gid += nb * NTHREADS) {
    const int s = gid >> 4, j = gid & 15, f = j & 7;
    const float pos = (float)(j < 8 ? (s >> 6) : (s & 63));
    const float inv = 1.0f / powf(10000.f, (float)f / 8.f);
    const float ang = pos * inv;
    float* R = (float*)(p.ws + OFF_ROPEB);
    R[gid] = cosf(ang); R[1024 * 16 + gid] = sinf(ang);
  }
  float km0 = 0.f, km1 = 0.f, km2 = 0.f, km3 = 0.f;
  {
    const int stride = nb * NTHREADS;
    auto conv_a = [&](int gid, float v) {
      const int cd = gid & 127, pp = (gid >> 7) & 511, l = (gid >> 16) & 1, j = gid >> 17;
      ((bf16_t*)(p.ws + OFF_KA))[(size_t)l * KA_L + (size_t)(NCTX + j * 1536 + 1024 + pp) * 128 + cd] = f2bf(v);
      float ss = v * v;
#pragma unroll
      for (int o = 32; o > 0; o >>= 1) ss += __shfl_xor(ss, o);
      if (l == 0) km0 = fmaxf(km0, ss); else km2 = fmaxf(km2, ss);
    };
    auto src_a = [&](int gid) { return p.cache_a[((size_t)(gid >> 7) * 2) * 128 + (gid & 127)]; };
    int gid = bid * NTHREADS + t;
    for (; gid + 3 * stride < 524288; gid += 4 * stride) {
      const float v0 = src_a(gid), v1 = src_a(gid + stride), v2 = src_a(gid + 2 * stride), v3 = src_a(gid + 3 * stride);
      conv_a(gid, v0); conv_a(gid + stride, v1); conv_a(gid + 2 * stride, v2); conv_a(gid + 3 * stride, v3);
    }
    for (; gid < 524288; gid += stride) conv_a(gid, src_a(gid));
    auto conv_b = [&](int g2, float v) {
      const int cd = g2 & 255, pp = (g2 >> 8) & 511, l = (g2 >> 17) & 1, j = g2 >> 18;
      ((bf16_t*)(p.ws + OFF_KB))[(size_t)l * KB_L + (size_t)(NCTX + j * 1536 + 1024 + pp) * 256 + cd] = f2bf(v);
      float ss = v * v;
#pragma unroll
      for (int o = 16; o > 0; o >>= 1) ss += __shfl_xor(ss, o);
      if (l == 0) km1 = fmaxf(km1, ss); else km3 = fmaxf(km3, ss);
    };
    auto src_b = [&](int g2) { return p.cache_b[((size_t)(g2 >> 8) * 2) * 256 + (g2 & 255)]; };
    gid = bid * NTHREADS + t;
    for (; gid + 3 * stride < 1048576; gid += 4 * stride) {
      const float v0 = src_b(gid), v1 = src_b(gid + stride), v2 = src_b(gid + 2 * stride), v3 = src_b(gid + 3 * stride);
      conv_b(gid, v0); conv_b(gid + stride, v1); conv_b(gid + 2 * stride, v2); conv_b(gid + 3 * stride, v3);
    }
    for (; gid < 1048576; gid += stride) conv_b(gid, src_b(gid));
  }
  {
    km1 = fmaxf(km1, __shfl_xor(km1, 32)); km3 = fmaxf(km3, __shfl_xor(km3, 32));
    __syncthreads();
    if ((t & 63) == 0) { float* sm = lf + (t >> 6) * 4; sm[0] = km0; sm[1] = km1; sm[2] = km2; sm[3] = km3; }
    __syncthreads();
    if (t < 4) ((float*)(p.ws + OFF_KMAXP))[bid * 4 + t] = fmaxf(fmaxf(lf[t], lf[4 + t]), fmaxf(lf[8 + t], lf[12 + t]));
    __syncthreads();
  }
}

DEVI void p0b(const Params& p, char* lds) {
  const int t = tid(), nb = gridDim.x, bid = blockIdx.x;
  float* lf = (float*)lds;
  for (int it = bid; it < 256; it += nb) {
    const int l = it >> 7, kt = (it >> 3) & 15, ntl = it & 7;
    const float* U = p.w_in + (size_t)l * 1024 * 2816 + (size_t)(kt * 64) * 2816 + 2304;
    const float* W = (const float*)(p.ws + OFF_W12) + (size_t)l * 256 * 512 + ntl * 64;
    float* Us = lf;
    float* Ws = lf + 64 * 33;
    const int tk = t >> 4, tn = t & 15;
    float a[4][4];
#pragma unroll
    for (int i = 0; i < 4; ++i)
#pragma unroll
      for (int j = 0; j < 4; ++j) a[i][j] = 0.f;
    for (int rc = 0; rc < 8; ++rc) {
#pragma unroll
      for (int i = 0; i < 8; ++i) { const int e = t + 256 * i, kk = e >> 5, rr = e & 31; Us[kk * 33 + rr] = U[(size_t)kk * 2816 + rc * 32 + rr]; }
#pragma unroll
      for (int i = 0; i < 8; ++i) { const int e = t + 256 * i, rr = e >> 6, nn = e & 63; Ws[rr * 64 + nn] = W[(size_t)(rc * 32 + rr) * 512 + nn]; }
      __syncthreads();
#pragma unroll 8
      for (int r = 0; r < 32; ++r) {
        const float4 w = *(const float4*)(Ws + r * 64 + tn * 4);
#pragma unroll
        for (int i = 0; i < 4; ++i) { const float u = Us[(tk * 4 + i) * 33 + r]; a[i][0] += u * w.x; a[i][1] += u * w.y; a[i][2] += u * w.z; a[i][3] += u * w.w; }
      }
      __syncthreads();
    }
    bf16_t* dst = (bf16_t*)(p.ws + OFF_WTIN) + (size_t)l * 3072 * LDP + (size_t)(2304 + ntl * 64 + tn * 4) * LDP + kt * 64 + tk * 4;
#pragma unroll
    for (int j = 0; j < 4; ++j) st_bf4(dst + (size_t)j * LDP, a[0][j], a[1][j], a[2][j], a[3][j]);
    {
      float* red = lf;
#pragma unroll
      for (int cnd = 0; cnd < 5; ++cnd) {
        const float4 sh = *(const float4*)((const float*)(p.ws + OFF_MOD) + (size_t)(l * 5 + cnd) * 3072 + kt * 64 + tk * 4);
#pragma unroll
        for (int j = 0; j < 4; ++j) red[(tk * 5 + cnd) * 64 + tn * 4 + j] = sh.x * a[0][j] + sh.y * a[1][j] + sh.z * a[2][j] + sh.w * a[3][j];
      }
      __syncthreads();
      for (int o = t; o < 320; o += NTHREADS) {
        const int cnd = o >> 6, n = o & 63;
        float sum = 0.f;
#pragma unroll
        for (int g = 0; g < 16; ++g) sum += red[(g * 5 + cnd) * 64 + n];
        ((float*)(p.ws + OFF_SHWP))[((size_t)(l * 16 + kt) * 5 + cnd) * 512 + ntl * 64 + n] = sum;
      }
      __syncthreads();
    }
  }
  {
    const int lane = t & 63, wave = t >> 6;
    const float* MOD = (const float*)(p.ws + OFF_MOD);
    for (int row = bid * 4 + wave; row < NTOK; row += nb * 4) {
      const float* xa = opq(p.x_prompt); const float* xb = opq(p.x_sample);
      const float* x = row < NCTX ? xa + (size_t)row * 1024 : xb + (size_t)(row - NCTX) * 1024;
      const int cond = row < NCTX ? 0 : 1 + ((row - NCTX) >> 10);
      const float* sc = MOD + (size_t)cond * 3072 + 1024;
      bf16_t* hp = (bf16_t*)(p.ws + OFF_HP) + (size_t)row * LDP;
      float ss = 0.f;
      float4 xv[4], gv[4], sv[4];
#pragma unroll
      for (int i = 0; i < 4; ++i) { const int k = i * 256 + lane * 4; xv[i] = *(const float4*)(x + k); gv[i] = *(const float4*)(p.norm_g + k); sv[i] = *(const float4*)(sc + k); }
#pragma unroll
      for (int i = 0; i < 4; ++i) {
        const int k = i * 256 + lane * 4;
        ss += xv[i].x * xv[i].x + xv[i].y * xv[i].y + xv[i].z * xv[i].z + xv[i].w * xv[i].w;
        st_bf4(hp + k, xv[i].x * gv[i].x * (1.f + sv[i].x), xv[i].y * gv[i].y * (1.f + sv[i].y), xv[i].z * gv[i].z * (1.f + sv[i].z), xv[i].w * gv[i].w * (1.f + sv[i].w));
      }
#pragma unroll
      for (int o = 32; o > 0; o >>= 1) ss += __shfl_xor(ss, o);
      if (lane < 16) ((float*)(p.ws + OFF_SSQ))[(size_t)row * 16 + lane] = lane == 0 ? ss : 0.f;
    }
  }
  {
  const int lane = t & 63, wave = t >> 6;
  if (blockIdx.x == 0 && wave == 0) {
    const float4* pp = (const float4*)(p.ws + OFF_KMAXP);
    float4 m = make_float4(0.f, 0.f, 0.f, 0.f);
    for (int i = lane; i < (int)gridDim.x; i += 64) { const float4 v = pp[i]; m.x = fmaxf(m.x, v.x); m.y = fmaxf(m.y, v.y); m.z = fmaxf(m.z, v.z); m.w = fmaxf(m.w, v.w); }
#pragma unroll
    for (int o = 32; o > 0; o >>= 1) { m.x = fmaxf(m.x, __shfl_xor(m.x, o)); m.y = fmaxf(m.y, __shfl_xor(m.y, o)); m.z = fmaxf(m.z, __shfl_xor(m.z, o)); m.w = fmaxf(m.w, __shfl_xor(m.w, o)); }
    if (lane == 0) *(float4*)(p.ws + OFF_KMAX) = m;
  }
  const float* MOD = (const float*)(p.ws + OFF_MOD);
  for (int idx = blockIdx.x * 4 + wave; idx < 2 * 2560; idx += gridDim.x * 4) {
    const int l = idx / 2560, n2 = idx % 2560, n = n2 < 2304 ? n2 : n2 + 512;
    const bf16_t* w = (const bf16_t*)(p.ws + OFF_WTIN) + (size_t)l * 3072 * LDP + (size_t)n * LDP + lane * 16;
    const uint4 w0 = *(const uint4*)w, w1 = *(const uint4*)(w + 8);
    float wf[16];
    wf[0] = __uint_as_float(w0.x << 16); wf[1] = __uint_as_float(w0.x & 0xffff0000u); wf[2] = __uint_as_float(w0.y << 16); wf[3] = __uint_as_float(w0.y & 0xffff0000u);
    wf[4] = __uint_as_float(w0.z << 16); wf[5] = __uint_as_float(w0.z & 0xffff0000u); wf[6] = __uint_as_float(w0.w << 16); wf[7] = __uint_as_float(w0.w & 0xffff0000u);
    wf[8] = __uint_as_float(w1.x << 16); wf[9] = __uint_as_float(w1.x & 0xffff0000u); wf[10] = __uint_as_float(w1.y << 16); wf[11] = __uint_as_float(w1.y & 0xffff0000u);
    wf[12] = __uint_as_float(w1.z << 16); wf[13] = __uint_as_float(w1.z & 0xffff0000u); wf[14] = __uint_as_float(w1.w << 16); wf[15] = __uint_as_float(w1.w & 0xffff0000u);
#pragma unroll
    for (int cnd = 0; cnd < 5; ++cnd) {
      const float* sh = MOD + (size_t)(l * 5 + cnd) * 3072 + lane * 16;
      float s = 0.f;
#pragma unroll
      for (int i = 0; i < 4; ++i) { const float4 s4 = *(const float4*)(sh + i * 4); s += s4.x * wf[i * 4] + s4.y * wf[i * 4 + 1] + s4.z * wf[i * 4 + 2] + s4.w * wf[i * 4 + 3]; }
#pragma unroll
      for (int o = 32; o > 0; o >>= 1) s += __shfl_xor(s, o);
      if (lane == 0) ((float*)(p.ws + OFF_SHW))[(size_t)(l * 5 + cnd) * 3072 + n] = s;
    }
  }
  }
}

constexpr int NPHASES = 8;
DEVI void run_phase(const Params& p, int ph, char* lds) {
  if (ph == 0) { p0a(p, lds); return; }
  if (ph == 1) { p0b(p, lds); return; }
  const int l = (ph - 2) / 3, k = (ph - 2) % 3;
  if (k == 0) {
    for (int it = blockIdx.x; it < 96 * 24; it += gridDim.x) { const int nt = it / 96, mt = it % 96; g1_tile(p, l, mt, nt, lds); }
  } else if (k == 1) {
#if COOP
    unsigned* ctr = (unsigned*)(p.ws + OFF_BAR + 14336) + l * 64;
    volatile LAS unsigned* sh = (volatile LAS unsigned*)(lds + LDS_BYTES) + 2;
    for (;;) {
      if (threadIdx.x == 0) sh[0] = __hip_atomic_fetch_add(ctr, 1u, __ATOMIC_RELAXED, __HIP_MEMORY_SCOPE_AGENT);
      __syncthreads();
      const int u = (int)sh[0];
      __syncthreads();
      if (u >= ATT_UNITS) break;
      att_phase_unit(p, l, u, lds);
    }
#else
    for (int u = blockIdx.x; u < ATT_UNITS; u += gridDim.x) att_phase_unit(p, l, u, lds);
#endif
  } else {
    for (int it = blockIdx.x; it < 768; it += gridDim.x) {
      const int x = it & 7, j = it >> 3, nt = j & 7, mt = (j >> 3) * 8 + x;
      g2_tile(p, l, mt, nt, lds);
    }
  }
}

__global__ void __launch_bounds__(NTHREADS, 2) __attribute__((amdgpu_waves_per_eu(2, 2))) fwd_mega(Params p) {
  extern __shared__ __attribute__((aligned(16))) char lds[];
  cg::grid_group grid = cg::this_grid();
  if (p.ws == nullptr) grid.sync();
  volatile LAS unsigned* st = (volatile LAS unsigned*)(lds + LDS_BYTES);
  if (threadIdx.x == 0) { st[0] = 0u; st[1] = 0u; }
  __syncthreads();
  XcdBarrier xb = xcd_barrier_post((unsigned*)(p.ws + OFF_BAR), st);
  for (int ph = 0; ph < NPHASES; ++ph) {
#if DUPMASK
    if ((DUPMASK >> ph) & 1) { run_phase(p, ph, lds); xcd_barrier(xb); }
#endif
    run_phase(p, ph, lds);
    if (ph + 1 < NPHASES) xcd_barrier(xb);
  }
}

__global__ void __launch_bounds__(NTHREADS, 2) __attribute__((amdgpu_waves_per_eu(2, 2))) fwd_phase(Params p, int ph) {
  extern __shared__ __attribute__((aligned(16))) char lds[];
  run_phase(p, ph, lds);
}

extern "C" void kernel_launch(void* const* d_in, const int* in_sizes, int n_in, void* d_out, int out_size, void* d_ws, size_t ws_size, hipStream_t stream) {
  static int grid_blocks = 0;
  if (!grid_blocks) {
    int dev = 0, cus = 0, per_cu = 0;
    hipGetDevice(&dev);
    hipDeviceGetAttribute(&cus, hipDeviceAttributeMultiprocessorCount, dev);
#if COOP
    hipFuncSetAttribute((const void*)fwd_mega, hipFuncAttributeMaxDynamicSharedMemorySize, LDS_TOTAL);
    hipOccupancyMaxActiveBlocksPerMultiprocessor(&per_cu, (const void*)fwd_mega, NTHREADS, LDS_TOTAL);
    fprintf(stderr, "occupancy query: %d blocks per CU, %d CUs\n", per_cu, cus);
    per_cu = 2;
#else
    hipFuncSetAttribute((const void*)fwd_phase, hipFuncAttributeMaxDynamicSharedMemorySize, LDS_BYTES);
    hipOccupancyMaxActiveBlocksPerMultiprocessor(&per_cu, (const void*)fwd_phase, NTHREADS, LDS_BYTES);
#endif
    if (per_cu < 1) per_cu = 1;
    if (per_cu > 2) per_cu = 2;
    grid_blocks = cus * per_cu;
    if (ws_size < WS_END) fprintf(stderr, "workspace too small: %zu < %zu\n", ws_size, (size_t)WS_END);
  }
  Params p{};
  const float** pp = (const float**)&p;
  for (int i = 0; i < 21; ++i) pp[i] = (const float*)d_in[i];
  p.out = (float*)d_out;
  p.ws = (char*)d_ws;
#if COOP
  void* args[] = {&p};
  hipMemsetAsync((char*)d_ws + OFF_BAR, 0, 16384, stream);
  hipError_t e = hipLaunchCooperativeKernel((const void*)fwd_mega, dim3(grid_blocks), dim3(NTHREADS), args, LDS_TOTAL, stream);
  if (e != hipSuccess) fprintf(stderr, "cooperative launch failed: %s (grid %d)\n", hipGetErrorString(e), grid_blocks);
#else
  for (int ph = 0; ph < NPHASES; ++ph) hipLaunchKernelGGL(fwd_phase, dim3(grid_blocks), dim3(NTHREADS), LDS_BYTES, stream, p, ph);
#endif
}
```

```cpp
#include <hip/hip_runtime.h>
#include <hip/hip_cooperative_groups.h>
#include <stdint.h>
#include <cstdio>
namespace cg = cooperative_groups;

#ifndef COOP
#define COOP 1
#endif
#ifndef DUPMASK
#define DUPMASK 0
#endif

typedef unsigned short bf16_t;
typedef short bf16x8 __attribute__((ext_vector_type(8)));
typedef float f32x16 __attribute__((ext_vector_type(16)));
typedef uint32_t u32x4 __attribute__((ext_vector_type(4)));
#define DEVI __device__ __forceinline__

constexpr int NTOK = 12288, NCTX = 8192, DM = 1024, N1 = 3072;
constexpr int NTHREADS = 256;
constexpr int LDP = 1088;
constexpr int LDS_BYTES = 73728;
constexpr int LDS_TOTAL = LDS_BYTES + 16;
constexpr float EPS = 1e-6f;
constexpr float LOG2E = 1.4426950408889634f;

constexpr size_t OFF_WTIN  = 0;
constexpr size_t OFF_WTOUT = OFF_WTIN  + 2ull * 3072 * LDP * 2;
constexpr size_t OFF_W12   = OFF_WTOUT + 2ull * 1024 * LDP * 2;
constexpr size_t OFF_T256  = OFF_W12   + 2ull * 256 * 512 * 4;
constexpr size_t OFF_T1024 = OFF_T256  + 256ull * 512 * 2;
constexpr size_t OFF_ROPEA = OFF_T1024 + 1024ull * 2048 * 2;
constexpr size_t OFF_ROPEB = OFF_ROPEA + 2ull * 1024 * 32 * 4;
constexpr size_t OFF_MOD   = OFF_ROPEB + 2ull * 1024 * 16 * 4;
constexpr size_t OFF_SHW   = OFF_MOD   + 2ull * 5 * 3072 * 4;
constexpr size_t OFF_SSQ   = OFF_SHW   + 2ull * 5 * 3072 * 4;
constexpr size_t OFF_HP    = OFF_SSQ   + 12288ull * 16 * 4;
constexpr size_t OFF_QA    = OFF_HP    + 12288ull * LDP * 2;
constexpr size_t OFF_KA    = OFF_QA    + 12288ull * 512 * 2;
constexpr size_t OFF_VTA   = OFF_KA    + 2ull * 14336 * 128 * 2;
constexpr size_t OFF_QB    = OFF_VTA   + 2ull * 14336 * 128 * 2;
constexpr size_t OFF_KB    = OFF_QB    + 12288ull * 256 * 2;
constexpr size_t OFF_VTB   = OFF_KB    + 2ull * 14336 * 256 * 2;
constexpr size_t OFF_G     = OFF_VTB   + 2ull * 14336 * 256 * 2;
constexpr size_t OFF_PQT   = OFF_G     + 12288ull * 1024 * 2;
constexpr size_t OFF_MIX   = OFF_PQT   + 12288ull * 512 * 2;
constexpr size_t OFF_Y1    = OFF_MIX   + 12288ull * LDP * 2;
constexpr size_t OFF_BAR   = OFF_Y1    + 12288ull * 1024 * 4;
constexpr size_t OFF_KMAX  = OFF_BAR   + 16384;
constexpr size_t OFF_KMAXP = OFF_KMAX  + 256;
constexpr size_t OFF_SHWP  = OFF_KMAXP + 16384;
constexpr size_t WS_END    = OFF_SHWP  + 2ull * 16 * 5 * 512 * 4;

constexpr size_t KA_L = 14336ull * 128, KB_L = 14336ull * 256;

struct Params {
  const float *x_prompt, *x_sample, *cache_a, *cache_b, *c, *c_ctx, *norm_g, *w_mod, *b_mod, *w_in,
      *qn_a, *kn_a, *qn_b, *kn_b, *lq1, *lk1, *lq2, *lk2, *subln_g, *w_c, *w_out;
  float* out;
  char* ws;
};

DEVI uint32_t pk_bf16(float lo, float hi) { uint32_t r; asm("v_cvt_pk_bf16_f32 %0, %1, %2" : "=v"(r) : "v"(lo), "v"(hi)); return r; }
DEVI bf16_t f2bf(float f) { return (bf16_t)(pk_bf16(f, 0.f) & 0xffffu); }
DEVI float bf2f(bf16_t b) { return __uint_as_float(((uint32_t)b) << 16); }
DEVI const float* opq(const float* x) { asm volatile("" : "+s"(x)); return x; }
DEVI int tid() { int t = threadIdx.x; asm volatile("" : "+v"(t)); return t; }
DEVI float silu(float v) { return v * __builtin_amdgcn_rcpf(1.f + __expf(-v)); }
DEVI f32x16 mfma32(bf16x8 a, bf16x8 b, f32x16 c) { return __builtin_amdgcn_mfma_f32_32x32x16_bf16(a, b, c, 0, 0, 0); }
DEVI void st_bf4(bf16_t* p, float a, float b, float c, float d) { uint2 u; u.x = pk_bf16(a, b); u.y = pk_bf16(c, d); *(uint2*)p = u; }


#define XB_TMO      128
#define XB_XCNT(j)  (256  + 64 * (j))
#define XB_XSUB(j)  (1280 + 64 * (j))
#define XB_XGEN(j)  (2304 + 64 * (j))
#define XB_TOP      3328
#define XB_TOPGEN   3392
#define XCD_BAR_WORDS 3456
#define XB_SPIN_CAP (1u << 20)
#define LAS __attribute__((address_space(3)))
DEVI unsigned xb_ld(unsigned* p)              { return __hip_atomic_load(p, __ATOMIC_RELAXED, __HIP_MEMORY_SCOPE_AGENT); }
DEVI unsigned xb_add(unsigned* p, unsigned v) { return __hip_atomic_fetch_add(p, v, __ATOMIC_RELAXED, __HIP_MEMORY_SCOPE_AGENT); }
DEVI unsigned xb_xcc_id() { return (unsigned)__builtin_amdgcn_s_getreg((3 << 11) | 20) & 0xFu; }
#define XB_SPIN(cond, bar) do { unsigned _sp = 0; while (cond) { __builtin_amdgcn_s_sleep(1); \
    if ((++_sp & 255u) == 0u) { if (xb_ld(&(bar)[XB_TMO])) break; if (_sp > XB_SPIN_CAP) { atomicAdd(&(bar)[XB_TMO], 1u); break; } } } } while (0)
struct XcdBarrier { unsigned* bar; unsigned x; volatile LAS unsigned* st; };
DEVI XcdBarrier xcd_barrier_post(unsigned* bar, volatile LAS unsigned* st) {
  XcdBarrier b; b.bar = bar; b.x = xb_xcc_id(); b.st = st;
  if (threadIdx.x == 0) (void)xb_add(&bar[XB_XCNT(b.x)], 1u);
  return b;
}
DEVI void xcd_barrier_complete(unsigned* bar, unsigned x, unsigned& nloc, unsigned& nx) {
  const unsigned G = gridDim.x * gridDim.y * gridDim.z;
  unsigned sum, cnt, mine, sp = 0u;
  for (;;) {
    sum = 0u; cnt = 0u; mine = 0u;
#pragma unroll
    for (unsigned j = 0; j < 16; ++j) { const unsigned c = xb_ld(&bar[XB_XCNT(j)]); sum += c; cnt += (c > 0u) ? 1u : 0u; mine = (j == x) ? c : mine; }
    if (sum == G) break;
    __builtin_amdgcn_s_sleep(1);
    if ((++sp & 255u) == 0u) { if (xb_ld(&bar[XB_TMO])) break; if (sp > XB_SPIN_CAP) { atomicAdd(&bar[XB_TMO], 1u); break; } }
  }
  nloc = mine > 0u ? mine : 1u; nx = cnt > 0u ? cnt : 1u;
}
DEVI void xcd_barrier(const XcdBarrier& b) {
  asm volatile("s_waitcnt vmcnt(0)" ::: "memory");
  __syncthreads();
  if (threadIdx.x == 0) {
    unsigned* bar = b.bar;
    __builtin_amdgcn_s_waitcnt(0);
    unsigned nloc = b.st[0], nx = b.st[1];
    if (nloc == 0u) { xcd_barrier_complete(bar, b.x, nloc, nx); b.st[0] = nloc; b.st[1] = nx; }
    const unsigned old = xb_add(&bar[XB_XSUB(b.x)], 1u);
    const unsigned gen = old / nloc;
    if (old + 1u == (gen + 1u) * nloc) {
      __builtin_amdgcn_fence(__ATOMIC_RELEASE, "agent");
      asm volatile("s_waitcnt vmcnt(0)" ::: "memory");
      const unsigned og = xb_add(&bar[XB_TOP], 1u);
      const unsigned tg = og / nx;
      if (og + 1u == (tg + 1u) * nx) xb_add(&bar[XB_TOPGEN], 1u);
      else XB_SPIN(xb_ld(&bar[XB_TOPGEN]) == tg, bar);
      __builtin_amdgcn_fence(__ATOMIC_ACQUIRE, "agent");
      xb_add(&bar[XB_XGEN(b.x)], 1u);
      asm volatile("s_waitcnt vmcnt(0)" ::: "memory");
    } else {
      XB_SPIN(xb_ld(&bar[XB_XGEN(b.x)]) == gen, bar);
      __builtin_amdgcn_fence(__ATOMIC_ACQUIRE, "agent");
      asm volatile("s_waitcnt vmcnt(0)" ::: "memory");
    }
  }
  __syncthreads();
}

template <int TN = 2>
DEVI void gemm_core(const bf16_t* __restrict__ Ag, int lda, const bf16_t* __restrict__ Bg, int ldb, int K,
                    f32x16 (&acc)[TN][2], char* lds) {
  const int t = tid(), lane = t & 63, wave = t >> 6, wm = wave >> 1, wn = wave & 1;
  const int lr = lane & 31, h = lane >> 5;
#pragma unroll
  for (int a = 0; a < TN; ++a)
#pragma unroll
    for (int b = 0; b < 2; ++b)
#pragma unroll
      for (int i = 0; i < 16; ++i) acc[a][b][i] = 0.f;
  const int nk = K >> 6;
  const int r8 = lane >> 3, cp = lane & 7;
  const bf16_t* as_[4];
  const bf16_t* bs_[2 * TN];
#pragma unroll
  for (int i = 0; i < 4; ++i) { const int r = (wave * 4 + i) * 8 + r8; as_[i] = Ag + (size_t)r * lda + ((cp ^ ((r >> 1) & 7)) << 3); }
#pragma unroll
  for (int i = 0; i < 2 * TN; ++i) { const int r = (wave * 2 * TN + i) * 8 + r8; bs_[i] = Bg + (size_t)r * ldb + ((cp ^ ((r >> 1) & 7)) << 3); }
  LAS char* const l3a = (LAS char*)lds + wave * 4096;
  LAS char* const l3b = (LAS char*)lds + 16384 + wave * (2048 * TN);
#define GLDS(SRC, DST) __builtin_amdgcn_global_load_lds((const unsigned*)(SRC), (LAS unsigned*)(DST), 16, 0, 0)
#define DMA(BUF, KO) { \
    _Pragma("unroll") for (int i_ = 0; i_ < 4; ++i_) GLDS(as_[i_] + (KO), l3a + (BUF) * 32768 + i_ * 1024); \
    _Pragma("unroll") for (int i_ = 0; i_ < 2 * TN; ++i_) GLDS(bs_[i_] + (KO), l3b + (BUF) * 32768 + i_ * 1024); }
  const int swz = (lr >> 1) & 7;
  const int offA = (wm * 64 + lr) * 128, offB = 16384 + (wn * 32 * TN + lr) * 128;
#define COMPUTE(SA) { const char* s_ = (SA); \
    _Pragma("unroll") for (int ks = 0; ks < 4; ++ks) { bf16x8 fa[TN], fb[2]; const int co = ((ks * 2 + h) ^ swz) << 4; \
      _Pragma("unroll") for (int j = 0; j < 2; ++j) fb[j] = *(const bf16x8*)(s_ + offA + j * 4096 + co); \
      _Pragma("unroll") for (int j = 0; j < TN; ++j) fa[j] = *(const bf16x8*)(s_ + offB + j * 4096 + co); \
      _Pragma("unroll") for (int tn = 0; tn < TN; ++tn) _Pragma("unroll") for (int tm = 0; tm < 2; ++tm) acc[tn][tm] = mfma32(fa[tn], fb[tm], acc[tn][tm]); } }
  DMA(0, 0);
  asm volatile("s_waitcnt vmcnt(0)" ::: "memory");
  __syncthreads();
  for (int kt = 0; kt < nk; ++kt) {
    if (kt + 1 < nk) DMA((kt + 1) & 1, (kt + 1) * 64);
    COMPUTE(lds + (kt & 1) * 32768);
    asm volatile("s_waitcnt vmcnt(0)" ::: "memory");
    __syncthreads();
  }
#undef GLDS
#undef DMA
#undef COMPUTE
}

DEVI void g1_tile(const Params& p, int l, int mt, int nt, char* lds) {
  const int m0 = mt * 128, n0 = nt * 128;
  const bf16_t* HP = (const bf16_t*)(p.ws + OFF_HP);
  const bf16_t* WT = (const bf16_t*)(p.ws + OFF_WTIN) + (size_t)l * 3072 * LDP;
  const int t = tid(), lane = t & 63, wave = t >> 6, wm = wave >> 1, wn = wave & 1, lr = lane & 31, h = lane >> 5;
  const int nb = n0 + wn * 64;
  const bool lat = m0 >= NCTX;
  const int jb = lat ? ((m0 - NCTX) >> 10) : 0;
  const int cond = lat ? 1 + jb : 0;
  int type;
  if (n0 < 512) type = 0; else if (n0 < 640) type = 1; else if (n0 < 768) type = 2;
  else if (n0 < 1280) type = 3;
  else if (n0 < 1536) type = 4; else if (n0 < 1792) type = 5; else if (n0 < 2048) type = 6;
  else if (n0 < 2304) type = 3;
  else if (n0 < 2816) type = 7;
  else type = 3;
  float* X = (float*)(lds + 65536);
  if (t < 128) {
    const float4* sp = (const float4*)((const float*)(p.ws + OFF_SSQ) + (size_t)(m0 + t) * 16);
    const float4 a = sp[0], b = sp[1], c4 = sp[2], d = sp[3];
    const float ss = ((a.x + a.y) + (a.z + a.w)) + ((b.x + b.y) + (b.z + b.w)) + ((c4.x + c4.y) + (c4.z + c4.w)) + ((d.x + d.y) + (d.z + d.w));
    X[t] = rsqrtf(ss * (1.f / 1024.f) + EPS);
  } else {
    const int col = t - 128;
    float shv;
    if (type == 7) {
      const float* sp = (const float*)(p.ws + OFF_SHWP) + ((size_t)(l * 16) * 5 + cond) * 512 + (n0 - 2304) + col;
      shv = 0.f;
#pragma unroll
      for (int g = 0; g < 16; ++g) shv += sp[(size_t)g * 5 * 512];
    } else shv = ((const float*)(p.ws + OFF_SHW))[(size_t)(l * 5 + cond) * 3072 + n0 + col];
    X[128 + col] = shv;
    float g = 1.f;
    if (type == 0) g = p.qn_a[l * 64 + (col & 63)];
    else if (type == 1) g = p.kn_a[l * 64 + (col & 63)];
    else if (type == 4) g = p.qn_b[l * 32 + (col & 31)];
    else if (type == 5) g = p.kn_b[l * 32 + (col & 31)];
    X[256 + col] = g;
  }
  f32x16 acc[2][2];
  gemm_core<2>(HP + (size_t)m0 * LDP, LDP, WT + (size_t)n0 * LDP, LDP, 1024, acc, lds);

  float sw[2][16];
#pragma unroll
  for (int tn = 0; tn < 2; ++tn)
#pragma unroll
    for (int q = 0; q < 4; ++q) { const float4 s4 = *(const float4*)(X + 128 + wn * 64 + tn * 32 + q * 8 + h * 4); sw[tn][q * 4 + 0] = s4.x; sw[tn][q * 4 + 1] = s4.y; sw[tn][q * 4 + 2] = s4.z; sw[tn][q * 4 + 3] = s4.w; }

  bf16_t* E = (bf16_t*)lds;
  const float* ropeA = (const float*)(p.ws + OFF_ROPEA);
  const float* ropeB = (const float*)(p.ws + OFF_ROPEB);

#pragma unroll
  for (int tm = 0; tm < 2; ++tm) {
    const int trow = wm * 64 + tm * 32 + lr;
    const int tok = m0 + trow;
    const float rstd = X[trow];
    float v[2][16];
#pragma unroll
    for (int tn = 0; tn < 2; ++tn)
#pragma unroll
      for (int i = 0; i < 16; ++i) v[tn][i] = rstd * acc[tn][tm][i] + sw[tn][i];

    int s, bq, Lk, krow; size_t vbA, vbB, pqb; int S;
    if (!lat) { bq = tok >> 8; s = tok & 255; Lk = 256; krow = tok; vbA = (size_t)bq * 32768; vbB = (size_t)bq * 65536; pqb = (size_t)bq * 131072; S = 256; }
    else { bq = jb; s = (tok - NCTX) & 1023; Lk = 1536; krow = NCTX + jb * 1536 + s; vbA = 1048576 + (size_t)jb * 196608; vbB = 2097152 + (size_t)jb * 393216; pqb = 32ull * 131072 + (size_t)jb * 524288; S = 1024; }

    if (type == 3) {
      bf16_t* G = E + trow * 136 + wn * 64 + h * 4;
#pragma unroll
      for (int tn = 0; tn < 2; ++tn)
#pragma unroll
        for (int q = 0; q < 4; ++q) st_bf4(G + tn * 32 + q * 8, silu(v[tn][q * 4]), silu(v[tn][q * 4 + 1]), silu(v[tn][q * 4 + 2]), silu(v[tn][q * 4 + 3]));
    } else if (type == 0 || type == 1) {
      float ss = 0.f;
#pragma unroll
      for (int tn = 0; tn < 2; ++tn)
#pragma unroll
        for (int i = 0; i < 16; ++i) ss += v[tn][i] * v[tn][i];
      ss += __shfl_xor(ss, 32);
      const float r = rsqrtf(ss * (1.f / 64.f) + EPS);
      const float* gp = X + 256 + wn * 64 + h * 4;
#pragma unroll
      for (int tn = 0; tn < 2; ++tn)
#pragma unroll
        for (int q = 0; q < 4; ++q) { const float4 g4 = *(const float4*)(gp + tn * 32 + q * 8); v[tn][q * 4] *= r * g4.x; v[tn][q * 4 + 1] *= r * g4.y; v[tn][q * 4 + 2] *= r * g4.z; v[tn][q * 4 + 3] *= r * g4.w; }
      if (type == 1 && !lat) {
        const int kvh = wn;
        float* o = p.out + 12582912ull + ((((size_t)(bq * 2 + l) * 256 + s) * 2 + 0) * 2 + kvh) * 64 + h * 4;
#pragma unroll
        for (int tn = 0; tn < 2; ++tn)
#pragma unroll
          for (int q = 0; q < 4; ++q) *(float4*)(o + tn * 32 + q * 8) = make_float4(v[tn][q * 4], v[tn][q * 4 + 1], v[tn][q * 4 + 2], v[tn][q * 4 + 3]);
      }
      if (lat) {
        const float* cp = ropeA + (size_t)s * 32 + h * 4;
        const float* sp = cp + 1024 * 32;
#pragma unroll
        for (int tn = 0; tn < 2; ++tn)
#pragma unroll
          for (int q = 0; q < 2; ++q) {
            const float4 c4 = *(const float4*)(cp + tn * 16 + q * 8), s4 = *(const float4*)(sp + tn * 16 + q * 8);
            const float cc[4] = {c4.x, c4.y, c4.z, c4.w}, sn[4] = {s4.x, s4.y, s4.z, s4.w};
#pragma unroll
            for (int e = 0; e < 4; ++e) { const float x1 = v[tn][q * 4 + e], x2 = v[tn][(q + 2) * 4 + e]; v[tn][q * 4 + e] = x1 * cc[e] - x2 * sn[e]; v[tn][(q + 2) * 4 + e] = x1 * sn[e] + x2 * cc[e]; }
          }
      }
      if (type == 0) {
        const float sc = 0.125f * LOG2E;
        bf16_t* Q = E + trow * 136 + wn * 64 + h * 4;
#pragma unroll
        for (int tn = 0; tn < 2; ++tn)
#pragma unroll
          for (int q = 0; q < 4; ++q) st_bf4(Q + tn * 32 + q * 8, v[tn][q * 4] * sc, v[tn][q * 4 + 1] * sc, v[tn][q * 4 + 2] * sc, v[tn][q * 4 + 3] * sc);
      } else {
        bf16_t* Kp = E + trow * 136 + wn * 64 + h * 4;
#pragma unroll
        for (int tn = 0; tn < 2; ++tn)
#pragma unroll
          for (int q = 0; q < 4; ++q) st_bf4(Kp + tn * 32 + q * 8, v[tn][q * 4], v[tn][q * 4 + 1], v[tn][q * 4 + 2], v[tn][q * 4 + 3]);
      }
    } else if (type == 2) {
      const int kvh = wn;
      if (!lat) {
        float* o = p.out + 12582912ull + ((((size_t)(bq * 2 + l) * 256 + s) * 2 + 1) * 2 + kvh) * 64 + h * 4;
#pragma unroll
        for (int tn = 0; tn < 2; ++tn)
#pragma unroll
          for (int q = 0; q < 4; ++q) *(float4*)(o + tn * 32 + q * 8) = make_float4(v[tn][q * 4], v[tn][q * 4 + 1], v[tn][q * 4 + 2], v[tn][q * 4 + 3]);
      }
      bf16_t* Vt = E + (wn * 64 + h * 4) * 136 + trow;
#pragma unroll
      for (int tn = 0; tn < 2; ++tn)
#pragma unroll
        for (int i = 0; i < 16; ++i) Vt[(tn * 32 + (i >> 2) * 8 + (i & 3)) * 136] = f2bf(v[tn][i]);
    } else if (type == 4 || type == 5) {
      const int hb = (nb - (type == 4 ? 1280 : 1536)) >> 6;
      const float* gp = X + 256 + wn * 64 + h * 4;
#pragma unroll
      for (int tn = 0; tn < 2; ++tn) {
        float ss = 0.f;
#pragma unroll
        for (int i = 0; i < 16; ++i) ss += v[tn][i] * v[tn][i];
        ss += __shfl_xor(ss, 32);
        const float r = rsqrtf(ss * (1.f / 32.f) + EPS);
#pragma unroll
        for (int q = 0; q < 4; ++q) { const float4 g4 = *(const float4*)(gp + q * 8); v[tn][q * 4] *= r * g4.x; v[tn][q * 4 + 1] *= r * g4.y; v[tn][q * 4 + 2] *= r * g4.z; v[tn][q * 4 + 3] *= r * g4.w; }
      }
      if (type == 5 && !lat) {
        float* o = p.out + 16777216ull + ((((size_t)(bq * 2 + l) * 256 + s) * 2 + 0) * 4 + hb) * 64 + h * 4;
#pragma unroll
        for (int tn = 0; tn < 2; ++tn)
#pragma unroll
          for (int q = 0; q < 4; ++q) *(float4*)(o + tn * 32 + q * 8) = make_float4(v[tn][q * 4], v[tn][q * 4 + 1], v[tn][q * 4 + 2], v[tn][q * 4 + 3]);
      }
      if (lat) {
        const float* cp = ropeB + (size_t)s * 16 + h * 4;
        const float* sp = cp + 1024 * 16;
#pragma unroll
        for (int hf = 0; hf < 2; ++hf) {
          const float4 c4 = *(const float4*)(cp + hf * 8), s4 = *(const float4*)(sp + hf * 8);
          const float cc[4] = {c4.x, c4.y, c4.z, c4.w}, sn[4] = {s4.x, s4.y, s4.z, s4.w};
#pragma unroll
          for (int tn = 0; tn < 2; ++tn)
#pragma unroll
            for (int e = 0; e < 4; ++e) { const float x1 = v[tn][(2 * hf) * 4 + e], x2 = v[tn][(2 * hf + 1) * 4 + e]; v[tn][(2 * hf) * 4 + e] = x1 * cc[e] - x2 * sn[e]; v[tn][(2 * hf + 1) * 4 + e] = x1 * sn[e] + x2 * cc[e]; }
        }
      }
      if (type == 4) {
        const float sc = 0.17677669529663687f * LOG2E;
        bf16_t* Q = E + trow * 136 + wn * 64 + h * 4;
#pragma unroll
        for (int tn = 0; tn < 2; ++tn)
#pragma unroll
          for (int q = 0; q < 4; ++q) st_bf4(Q + tn * 32 + q * 8, v[tn][q * 4] * sc, v[tn][q * 4 + 1] * sc, v[tn][q * 4 + 2] * sc, v[tn][q * 4 + 3] * sc);
      } else {
        bf16_t* Kp = E + trow * 136 + wn * 64 + h * 4;
#pragma unroll
        for (int tn = 0; tn < 2; ++tn)
#pragma unroll
          for (int q = 0; q < 4; ++q) st_bf4(Kp + tn * 32 + q * 8, v[tn][q * 4], v[tn][q * 4 + 1], v[tn][q * 4 + 2], v[tn][q * 4 + 3]);
      }
    } else if (type == 6) {
      const int hb = (nb - 1792) >> 6;
      if (!lat) {
        float* o = p.out + 16777216ull + ((((size_t)(bq * 2 + l) * 256 + s) * 2 + 1) * 4 + hb) * 64 + h * 4;
#pragma unroll
        for (int tn = 0; tn < 2; ++tn)
#pragma unroll
          for (int q = 0; q < 4; ++q) *(float4*)(o + tn * 32 + q * 8) = make_float4(v[tn][q * 4], v[tn][q * 4 + 1], v[tn][q * 4 + 2], v[tn][q * 4 + 3]);
      }
      bf16_t* Vt = E + (wn * 64 + h * 4) * 136 + trow;
#pragma unroll
      for (int tn = 0; tn < 2; ++tn)
#pragma unroll
        for (int i = 0; i < 16; ++i) Vt[(tn * 32 + (i >> 2) * 8 + (i & 3)) * 136] = f2bf(v[tn][i]);
    } else {
      bf16_t* PQ = E + (wn * 64 + h * 4) * 136 + trow;
#pragma unroll
      for (int tn = 0; tn < 2; ++tn)
#pragma unroll
        for (int i = 0; i < 16; ++i) PQ[(tn * 32 + (i >> 2) * 8 + (i & 3)) * 136] = f2bf(v[tn][i]);
    }
  }
  __syncthreads();
  {
    const int s0 = lat ? ((m0 - NCTX) & 1023) : (m0 & 255);
    const int krow0 = lat ? NCTX + jb * 1536 + s0 : m0;
    const int Lk0 = lat ? 1536 : 256, S0 = lat ? 1024 : 256;
    const int bq0 = lat ? jb : (m0 >> 8);
    bf16_t* dst; size_t stride;
    if (type == 0) { dst = (bf16_t*)(p.ws + OFF_QA) + (size_t)m0 * 512 + n0; stride = 512; }
    else if (type == 1) { dst = (bf16_t*)(p.ws + OFF_KA) + (size_t)l * KA_L + (size_t)krow0 * 128; stride = 128; }
    else if (type == 2) { dst = (bf16_t*)(p.ws + OFF_VTA) + (size_t)l * KA_L + (lat ? 1048576 + (size_t)jb * 196608 : (size_t)bq0 * 32768) + s0; stride = Lk0; }
    else if (type == 3) { const int g0 = n0 < 1280 ? n0 - 768 : (n0 < 2304 ? 512 + n0 - 2048 : 768 + n0 - 2816); dst = (bf16_t*)(p.ws + OFF_G) + (size_t)m0 * 1024 + g0; stride = 1024; }
    else if (type == 4) { dst = (bf16_t*)(p.ws + OFF_QB) + (size_t)m0 * 256 + (n0 - 1280); stride = 256; }
    else if (type == 5) { dst = (bf16_t*)(p.ws + OFF_KB) + (size_t)l * KB_L + (size_t)krow0 * 256 + (n0 - 1536); stride = 256; }
    else if (type == 6) { dst = (bf16_t*)(p.ws + OFF_VTB) + (size_t)l * KB_L + (lat ? 2097152 + (size_t)jb * 393216 : (size_t)bq0 * 65536) + (size_t)(n0 - 1792) * Lk0 + s0; stride = Lk0; }
    else { const int nn0 = n0 - 2304; dst = (bf16_t*)(p.ws + OFF_PQT) + (lat ? 32ull * 131072 + (size_t)jb * 524288 : (size_t)bq0 * 131072) + (size_t)(nn0 & 255) * (2 * S0) + (nn0 >> 8) * S0 + s0; stride = 2 * S0; }
    const int c = t & 15, r0 = t >> 4;
#pragma unroll
    for (int i = 0; i < 8; ++i) { const int r = r0 + 16 * i; *(uint4*)(dst + (size_t)r * stride + c * 8) = *(const uint4*)(E + r * 136 + c * 8); }
  }
  __syncthreads();
}

DEVI void g2_tile(const Params& p, int l, int mt, int nt, char* lds) {
  const int m0 = mt * 128, n0 = nt * 128;
  const bf16_t* MIX = (const bf16_t*)(p.ws + OFF_MIX);
  const bf16_t* WT = (const bf16_t*)(p.ws + OFF_WTOUT) + (size_t)l * 1024 * LDP;
  f32x16 acc[2][2];
  gemm_core<2>(MIX + (size_t)m0 * LDP, LDP, WT + (size_t)n0 * LDP, LDP, 1024, acc, lds);

  const int t = tid(), lane = t & 63, wave = t >> 6, wm = wave >> 1, wn = wave & 1, lr = lane & 31, h = lane >> 5;
  float* E = (float*)lds;
#pragma unroll
  for (int tm = 0; tm < 2; ++tm)
#pragma unroll
    for (int tn = 0; tn < 2; ++tn)
#pragma unroll
      for (int q = 0; q < 4; ++q)
        *(float4*)(E + (wm * 64 + tm * 32 + lr) * 132 + wn * 64 + tn * 32 + q * 8 + h * 4) =
            make_float4(acc[tn][tm][q * 4], acc[tn][tm][q * 4 + 1], acc[tn][tm][q * 4 + 2], acc[tn][tm][q * 4 + 3]);
  __syncthreads();
  const bool lat = m0 >= NCTX;
  const int cond = lat ? 1 + ((m0 - NCTX) >> 10) : 0;
  const float* MOD = (const float*)(p.ws + OFF_MOD);
  const int c4 = (t & 31) * 4, rb = t >> 5;
  const float4 g4 = *(const float4*)(MOD + (size_t)(l * 5 + cond) * 3072 + 2048 + n0 + c4);
  float4 gs = make_float4(0.f, 0.f, 0.f, 0.f);
  if (l == 0) {
    const float4 ng = *(const float4*)(p.norm_g + 1024 + n0 + c4);
    const float4 sc = *(const float4*)(MOD + (size_t)(5 + cond) * 3072 + 1024 + n0 + c4);
    gs = make_float4(ng.x * (1.f + sc.x), ng.y * (1.f + sc.y), ng.z * (1.f + sc.z), ng.w * (1.f + sc.w));
  }
  const float* xa = opq(p.x_prompt); const float* xb = opq(p.x_sample);
  const float* xin = (lat ? xb + (size_t)(m0 - NCTX) * 1024 : xa + (size_t)m0 * 1024) + n0 + c4;
  bf16_t* y1p = (bf16_t*)(p.ws + OFF_Y1) + (size_t)m0 * 1024 + n0 + c4;
  float* yout = p.out + (size_t)m0 * 1024 + n0 + c4;
  float4 xv[16];
  if (l == 0) {
#pragma unroll
    for (int i = 0; i < 16; ++i) xv[i] = *(const float4*)(xin + (size_t)(rb + 8 * i) * 1024);
  } else {
    uint2 xu[16];
#pragma unroll
    for (int i = 0; i < 16; ++i) xu[i] = *(const uint2*)(y1p + (size_t)(rb + 8 * i) * 1024);
#pragma unroll
    for (int i = 0; i < 16; ++i) xv[i] = make_float4(__uint_as_float(xu[i].x << 16), __uint_as_float(xu[i].x & 0xffff0000u), __uint_as_float(xu[i].y << 16), __uint_as_float(xu[i].y & 0xffff0000u));
  }
#pragma unroll
  for (int i = 0; i < 16; ++i) {
    const int r = rb + 8 * i;
    const float4 a4 = *(const float4*)(E + r * 132 + c4);
    float4 y;
    y.x = xv[i].x + g4.x * a4.x; y.y = xv[i].y + g4.y * a4.y; y.z = xv[i].z + g4.z * a4.z; y.w = xv[i].w + g4.w * a4.w;
    if (l != 0) *(float4*)(yout + (size_t)r * 1024) = y;
    if (l == 0) {
      st_bf4(y1p + (size_t)r * 1024, y.x, y.y, y.z, y.w);
      st_bf4((bf16_t*)(p.ws + OFF_HP) + (size_t)(m0 + r) * LDP + n0 + c4, y.x * gs.x, y.y * gs.y, y.z * gs.z, y.w * gs.w);
      float ss = y.x * y.x + y.y * y.y + y.z * y.z + y.w * y.w;
#pragma unroll
      for (int o = 16; o > 0; o >>= 1) ss += __shfl_xor(ss, o);
      if ((t & 31) == 0) *(float2*)((float*)(p.ws + OFF_SSQ) + (size_t)(m0 + r) * 16 + nt * 2) = make_float2(ss, 0.f);
    }
  }
  __syncthreads();
}

DEVI void g2_half_tile(const Params& p, int l, int mt, int nth, char* lds) {
  const int m0 = mt * 128, n0 = nth * 64;
  const bf16_t* MIX = (const bf16_t*)(p.ws + OFF_MIX);
  const bf16_t* WT = (const bf16_t*)(p.ws + OFF_WTOUT) + (size_t)l * 1024 * LDP;
  f32x16 acc[1][2];
  gemm_core<1>(MIX + (size_t)m0 * LDP, LDP, WT + (size_t)n0 * LDP, LDP, 1024, acc, lds);

  const int t = tid(), lane = t & 63, wave = t >> 6, wm = wave >> 1, wn = wave & 1, lr = lane & 31, h = lane >> 5;
  float* E = (float*)lds;
#pragma unroll
  for (int tm = 0; tm < 2; ++tm)
#pragma unroll
    for (int q = 0; q < 4; ++q)
      *(float4*)(E + (wm * 64 + tm * 32 + lr) * 68 + wn * 32 + q * 8 + h * 4) =
          make_float4(acc[0][tm][q * 4], acc[0][tm][q * 4 + 1], acc[0][tm][q * 4 + 2], acc[0][tm][q * 4 + 3]);
  __syncthreads();
  const bool lat = m0 >= NCTX;
  const int cond = lat ? 1 + ((m0 - NCTX) >> 10) : 0;
  const float* MOD = (const float*)(p.ws + OFF_MOD);
  const int c4 = (t & 15) * 4, rb = t >> 4;
  const float4 g4 = *(const float4*)(MOD + (size_t)(l * 5 + cond) * 3072 + 2048 + n0 + c4);
  float4 gs = make_float4(0.f, 0.f, 0.f, 0.f);
  if (l == 0) {
    const float4 ng = *(const float4*)(p.norm_g + 1024 + n0 + c4);
    const float4 sc = *(const float4*)(MOD + (size_t)(5 + cond) * 3072 + 1024 + n0 + c4);
    gs = make_float4(ng.x * (1.f + sc.x), ng.y * (1.f + sc.y), ng.z * (1.f + sc.z), ng.w * (1.f + sc.w));
  }
  const float* xa = opq(p.x_prompt); const float* xb = opq(p.x_sample);
  const float* xin = (lat ? xb + (size_t)(m0 - NCTX) * 1024 : xa + (size_t)m0 * 1024) + n0 + c4;
  bf16_t* y1p = (bf16_t*)(p.ws + OFF_Y1) + (size_t)m0 * 1024 + n0 + c4;
  float* yout = p.out + (size_t)m0 * 1024 + n0 + c4;
  float4 xv[8];
  if (l == 0) {
#pragma unroll
    for (int i = 0; i < 8; ++i) xv[i] = *(const float4*)(xin + (size_t)(rb + 16 * i) * 1024);
  } else {
    uint2 xu[8];
#pragma unroll
    for (int i = 0; i < 8; ++i) xu[i] = *(const uint2*)(y1p + (size_t)(rb + 16 * i) * 1024);
#pragma unroll
    for (int i = 0; i < 8; ++i) xv[i] = make_float4(__uint_as_float(xu[i].x << 16), __uint_as_float(xu[i].x & 0xffff0000u), __uint_as_float(xu[i].y << 16), __uint_as_float(xu[i].y & 0xffff0000u));
  }
#pragma unroll
  for (int i = 0; i < 8; ++i) {
    const int r = rb + 16 * i;
    const float4 a4 = *(const float4*)(E + r * 68 + c4);
    float4 y;
    y.x = xv[i].x + g4.x * a4.x; y.y = xv[i].y + g4.y * a4.y; y.z = xv[i].z + g4.z * a4.z; y.w = xv[i].w + g4.w * a4.w;
    if (l != 0) *(float4*)(yout + (size_t)r * 1024) = y;
    if (l == 0) {
      st_bf4(y1p + (size_t)r * 1024, y.x, y.y, y.z, y.w);
      st_bf4((bf16_t*)(p.ws + OFF_HP) + (size_t)(m0 + r) * LDP + n0 + c4, y.x * gs.x, y.y * gs.y, y.z * gs.z, y.w * gs.w);
      float ss = y.x * y.x + y.y * y.y + y.z * y.z + y.w * y.w;
#pragma unroll
      for (int o = 8; o > 0; o >>= 1) ss += __shfl_xor(ss, o);
      if ((t & 15) == 0) ((float*)(p.ws + OFF_SSQ))[(size_t)(m0 + r) * 16 + nth] = ss;
    }
  }
  __syncthreads();
}

DEVI void attn_rows_out(const Params& p, const float* Ot, int tokbase, int colbase, const float* gain, int lane);
DEVI void fourier_tile(const Params& p, int tok_seq0, int S, size_t pqb, int mt, int nt, char* lds) {
  const bf16_t* T = (const bf16_t*)(p.ws + (S == 256 ? OFF_T256 : OFF_T1024));
  const bf16_t* PQ = (const bf16_t*)(p.ws + OFF_PQT) + pqb;
  f32x16 acc[2][2];
  gemm_core<2>(T + (size_t)(mt * 128) * (2 * S), 2 * S, PQ + (size_t)(nt * 128) * (2 * S), 2 * S, 2 * S, acc, lds);
  const int t = tid(), lane = t & 63, wave = t >> 6, wm = wave >> 1, wn = wave & 1, lr = lane & 31, h = lane >> 5;
  float* Ot = (float*)lds + wave * (64 * 68);
#pragma unroll
  for (int tm = 0; tm < 2; ++tm)
#pragma unroll
    for (int tn = 0; tn < 2; ++tn)
#pragma unroll
      for (int q = 0; q < 4; ++q)
        *(float4*)(Ot + (tm * 32 + lr) * 68 + tn * 32 + q * 8 + h * 4) = make_float4(acc[tn][tm][q * 4], acc[tn][tm][q * 4 + 1], acc[tn][tm][q * 4 + 2], acc[tn][tm][q * 4 + 3]);
  const int tokb = tok_seq0 + mt * 128 + wm * 64, colb = 768 + nt * 128 + wn * 64;
  attn_rows_out(p, Ot, tokb, colb, nullptr, lane);
  attn_rows_out(p, Ot + 32 * 68, tokb + 32, colb, nullptr, lane);
}

DEVI void attn_rows_out(const Params& p, const float* Ot, int tokbase, int colbase, const float* gain, int lane) {
  const int rr = lane >> 3, ch = lane & 7;
  const bf16_t* Gb = (const bf16_t*)(p.ws + OFF_G) + (size_t)tokbase * 1024 + colbase + ch * 8;
  bf16_t* Mb = (bf16_t*)(p.ws + OFF_MIX) + (size_t)tokbase * LDP + colbase + ch * 8;
  uint4 g8[4];
#pragma unroll
  for (int i = 0; i < 4; ++i) g8[i] = *(const uint4*)(Gb + (size_t)(rr + 8 * i) * 1024);
  float4 s0 = make_float4(1.f, 1.f, 1.f, 1.f), s1 = s0;
  if (gain) { s0 = *(const float4*)(gain + ch * 8); s1 = *(const float4*)(gain + ch * 8 + 4); }
#pragma unroll
  for (int i = 0; i < 4; ++i) {
    const int row = rr + 8 * i;
    const float4 a = *(const float4*)(Ot + row * 68 + ch * 8), b = *(const float4*)(Ot + row * 68 + ch * 8 + 4);
    const uint4 g = g8[i];
    uint4 o;
    o.x = pk_bf16(a.x * s0.x * __uint_as_float(g.x << 16), a.y * s0.y * __uint_as_float(g.x & 0xffff0000u));
    o.y = pk_bf16(a.z * s0.z * __uint_as_float(g.y << 16), a.w * s0.w * __uint_as_float(g.y & 0xffff0000u));
    o.z = pk_bf16(b.x * s1.x * __uint_as_float(g.z << 16), b.y * s1.y * __uint_as_float(g.z & 0xffff0000u));
    o.w = pk_bf16(b.z * s1.z * __uint_as_float(g.w << 16), b.w * s1.w * __uint_as_float(g.w & 0xffff0000u));
    *(uint4*)(Mb + (size_t)row * LDP) = o;
  }
}

template <int NC>
DEVI void attn_unit(const Params& p, int l, int tok0, int head, char* lds) {
  const int t = tid(), lane = t & 63, wave = t >> 6, lr = lane & 31, h = lane >> 5;
  constexpr int KS = 4 / NC;
  const int comp = (NC == 1) ? 0 : (wave >> 1);
  const int qrow = (NC == 1) ? wave * 32 : (wave & 1) * 32;
  const bool lat = tok0 >= NCTX;
  int Lk, krow0; size_t vbase;
  if (!lat) { const int b = tok0 >> 8; Lk = 256; krow0 = b * 256; vbase = (NC == 1) ? (size_t)b * 32768 : (size_t)b * 65536; }
  else { const int j = (tok0 - NCTX) >> 10; Lk = 1536; krow0 = NCTX + j * 1536; vbase = (NC == 1) ? 1048576 + (size_t)j * 196608 : 2097152 + (size_t)j * 393216; }
  const bf16_t *Kg, *Vg, *Qg; int kst, qst;
  if (NC == 1) {
    const int kvh = head >> 2;
    Kg = (const bf16_t*)(p.ws + OFF_KA) + (size_t)l * KA_L + (size_t)krow0 * 128 + kvh * 64; kst = 128;
    Vg = (const bf16_t*)(p.ws + OFF_VTA) + (size_t)l * KA_L + vbase + (size_t)kvh * 64 * Lk;
    Qg = (const bf16_t*)(p.ws + OFF_QA) + (size_t)tok0 * 512 + head * 64; qst = 512;
  } else {
    Kg = (const bf16_t*)(p.ws + OFF_KB) + (size_t)l * KB_L + (size_t)krow0 * 256 + head * 64; kst = 256;
    Vg = (const bf16_t*)(p.ws + OFF_VTB) + (size_t)l * KB_L + vbase + (size_t)head * 64 * Lk;
    Qg = (const bf16_t*)(p.ws + OFF_QB) + (size_t)tok0 * 256 + head * 64; qst = 256;
  }
  bf16x8 qf[KS];
  {
    const bf16_t* qp = Qg + (size_t)(qrow + lr) * qst + comp * 32 + h * 8;
#pragma unroll
    for (int j = 0; j < KS; ++j) qf[j] = *(const bf16x8*)(qp + j * 16);
  }
  float Mb;
  {
    constexpr int DQ = 64 / NC;
    const float* gqp = (NC == 1) ? p.qn_a : p.qn_b;
    const float* gkp = (NC == 1) ? p.kn_a : p.kn_b;
    float gq = fabsf(gqp[l * DQ + (lane & (DQ - 1))]), gk = fabsf(gkp[l * DQ + (lane & (DQ - 1))]);
#pragma unroll
    for (int o = 32; o > 0; o >>= 1) { gq = fmaxf(gq, __shfl_xor(gq, o)); gk = fmaxf(gk, __shfl_xor(gk, o)); }
    const float qn = sqrtf((float)DQ) * gq;
    float kn = sqrtf((float)DQ) * gk;
    if (lat) kn = fmaxf(kn, sqrtf(((const float*)(p.ws + OFF_KMAX))[l * 2 + NC - 1]));
    Mb = qn * kn * ((NC == 1) ? 0.125f : 0.17677669529663687f) * LOG2E * 1.02f;
  }
  const bool fast = Mb < 56.f;
  f32x16 O[2];
  float mrun = -INFINITY, lsum = 0.f;
#pragma unroll
  for (int dt = 0; dt < 2; ++dt)
#pragma unroll
    for (int i = 0; i < 16; ++i) O[dt][i] = 0.f;
  const int c8 = t & 7, r0 = t >> 3;
  uint4 rk0, rk1, rv0, rv1;
  uint4 sk0, sk1, sv0, sv1;
  const bf16_t* kp = Kg + (size_t)r0 * kst + c8 * 8;
  const bf16_t* vp = Vg + (size_t)r0 * Lk + c8 * 8;
  const int nkt = Lk >> 6;
#define ALOAD0(KT) { rk0 = *(const uint4*)(kp + (size_t)((KT) * 64) * kst); rk1 = *(const uint4*)(kp + (size_t)((KT) * 64 + 32) * kst); \
                     rv0 = *(const uint4*)(vp + (KT) * 64); rv1 = *(const uint4*)(vp + (size_t)32 * Lk + (KT) * 64); }
#define ALOAD1(KT) { sk0 = *(const uint4*)(kp + (size_t)((KT) * 64) * kst); sk1 = *(const uint4*)(kp + (size_t)((KT) * 64 + 32) * kst); \
                     sv0 = *(const uint4*)(vp + (KT) * 64); sv1 = *(const uint4*)(vp + (size_t)32 * Lk + (KT) * 64); }
#define AWRITE0(W) { *(uint4*)(W) = rk0; *(uint4*)((W) + 32 * 144) = rk1; *(uint4*)((W) + 9216) = rv0; *(uint4*)((W) + 9216 + 32 * 144) = rv1; }
#define AWRITE1(W) { *(uint4*)(W) = sk0; *(uint4*)((W) + 32 * 144) = sk1; *(uint4*)((W) + 9216) = sv0; *(uint4*)((W) + 9216 + 32 * 144) = sv1; }
  auto tile = [&](const char* base) {
    const char* sK = base + comp * 64;
    const char* sV = base + 9216;
#pragma unroll
    for (int kk = 0; kk < 2; ++kk) {
      asm volatile("" ::: "memory");
      bf16x8 pf[2];
      f32x16 S;
      const float sinit = fast ? -Mb : 0.f;
#pragma unroll
      for (int i = 0; i < 16; ++i) S[i] = sinit;
#pragma unroll
      for (int j = 0; j < KS; ++j) {
        const bf16x8 kf = *(const bf16x8*)(sK + ((kk * 32 + lr) * 72 + j * 16 + h * 8) * 2);
        S = mfma32(kf, qf[j], S);
      }
      if (fast) {
        float ps = 0.f;
#pragma unroll
        for (int i = 0; i < 16; ++i) { S[i] = __builtin_amdgcn_exp2f(S[i]); ps += S[i]; }
        lsum += ps;
      } else {
        float mx = S[0];
#pragma unroll
        for (int i = 1; i < 16; ++i) mx = fmaxf(mx, S[i]);
        mx = fmaxf(mx, __shfl_xor(mx, 32));
        const float mnew = fmaxf(mrun, mx);
        const float alpha = __builtin_amdgcn_exp2f(mrun - mnew);
        mrun = mnew;
        float ps = 0.f;
#pragma unroll
        for (int i = 0; i < 16; ++i) { S[i] = __builtin_amdgcn_exp2f(S[i] - mnew); ps += S[i]; }
        lsum = lsum * alpha + ps;
#pragma unroll
        for (int dt = 0; dt < 2; ++dt)
#pragma unroll
          for (int i = 0; i < 16; ++i) O[dt][i] *= alpha;
      }
#pragma unroll
      for (int s2 = 0; s2 < 2; ++s2) {
        u32x4 u;
        u.x = pk_bf16(S[8 * s2 + 0], S[8 * s2 + 1]); u.y = pk_bf16(S[8 * s2 + 2], S[8 * s2 + 3]);
        u.z = pk_bf16(S[8 * s2 + 4], S[8 * s2 + 5]); u.w = pk_bf16(S[8 * s2 + 6], S[8 * s2 + 7]);
        pf[s2] = __builtin_bit_cast(bf16x8, u);
      }
#pragma unroll
      for (int dt = 0; dt < 2; ++dt)
#pragma unroll
        for (int s2 = 0; s2 < 2; ++s2) {
          const char* va = sV + ((dt * 32 + lr) * 72 + kk * 32 + 16 * s2 + 4 * h) * 2;
          const uint2 v0 = *(const uint2*)va, v1 = *(const uint2*)(va + 16);
          u32x4 u; u.x = v0.x; u.y = v0.y; u.z = v1.x; u.w = v1.y;
          O[dt] = mfma32(__builtin_bit_cast(bf16x8, u), pf[s2], O[dt]);
        }
    }
  };
  char* const w0 = lds + (r0 * 72 + c8 * 8) * 2;
  char* const w1 = w0 + 18432;
  ALOAD1(0);
  ALOAD0(1);
  AWRITE1(w0);
  ALOAD1(2);
  __syncthreads();
  for (int kt = 0; kt < nkt - 2; kt += 2) {
    tile(lds);
    AWRITE0(w1);
    { const int kn = (kt + 3 < nkt) ? kt + 3 : nkt - 1; ALOAD0(kn); }
    __syncthreads();
    tile(lds + 18432);
    AWRITE1(w0);
    { const int kn = (kt + 4 < nkt) ? kt + 4 : nkt - 1; ALOAD1(kn); }
    __syncthreads();
  }
  tile(lds);
  AWRITE0(w1);
  __syncthreads();
  tile(lds + 18432);
  __syncthreads();
#undef ALOAD0
#undef ALOAD1
#undef AWRITE0
#undef AWRITE1
  const int tok = tok0 + qrow + lr;
  const float inv = 1.f / (lsum + __shfl_xor(lsum, 32));
  if (NC == 1) {
    float* Ot = (float*)lds + wave * (32 * 68);
#pragma unroll
    for (int dt = 0; dt < 2; ++dt)
#pragma unroll
      for (int q = 0; q < 4; ++q)
        *(float4*)(Ot + lr * 68 + dt * 32 + q * 8 + h * 4) = make_float4(O[dt][q * 4] * inv, O[dt][q * 4 + 1] * inv, O[dt][q * 4 + 2] * inv, O[dt][q * 4 + 3] * inv);
    attn_rows_out(p, Ot, tok0 + qrow, head * 64, nullptr, lane);
  } else {
    float* ex = (float*)lds + (size_t)(wave & 1) * 2048 + lane;
    if (comp == 1) {
#pragma unroll
      for (int dt = 0; dt < 2; ++dt)
#pragma unroll
        for (int i = 0; i < 16; ++i) ex[(dt * 16 + i) * 64] = O[dt][i] * inv;
    }
    __syncthreads();
    if (comp == 0) {
      float d1 = p.lq1[l * 32 + lr] * p.lk1[l * 32 + lr], d2 = p.lq2[l * 32 + lr] * p.lk2[l * 32 + lr];
#pragma unroll
      for (int o = 16; o > 0; o >>= 1) { d1 += __shfl_xor(d1, o); d2 += __shfl_xor(d2, o); }
      const float lam_init = (l == 0) ? 0.2f : 0.35550907f;
      const float lam = expf(d1) - expf(d2) + lam_init;
      float ss = 0.f;
#pragma unroll
      for (int dt = 0; dt < 2; ++dt)
#pragma unroll
        for (int i = 0; i < 16; ++i) { O[dt][i] = O[dt][i] * inv - lam * ex[(dt * 16 + i) * 64]; ss += O[dt][i] * O[dt][i]; }
      ss += __shfl_xor(ss, 32);
      const float r = rsqrtf(ss * (1.f / 64.f) + EPS) * (1.f - lam_init);
      float* Ot = (float*)(lds + 16384) + (wave & 1) * (32 * 68);
#pragma unroll
      for (int dt = 0; dt < 2; ++dt)
#pragma unroll
        for (int q = 0; q < 4; ++q)
          *(float4*)(Ot + lr * 68 + dt * 32 + q * 8 + h * 4) = make_float4(O[dt][q * 4] * r, O[dt][q * 4 + 1] * r, O[dt][q * 4 + 2] * r, O[dt][q * 4 + 3] * r);
      attn_rows_out(p, Ot, tok0 + qrow, 512 + head * 64, p.subln_g + l * 64, lane);
    }
    __syncthreads();
  }
}

DEVI void att_phase_unit(const Params& p, int l, int u, char* lds) {
  if (u < 64) { const int j = u >> 4, mt = (u >> 1) & 7, nt = u & 1; fourier_tile(p, NCTX + j * 1024, 1024, 32ull * 131072 + (size_t)j * 524288, mt, nt, lds); return; }
  u -= 64;
  if (u < 256) { const int j = u >> 6, head = (u >> 3) & 7, qb = u & 7; attn_unit<1>(p, l, NCTX + j * 1024 + qb * 128, head, lds); return; }
  u -= 256;
  if (u < 256) { const int j = u >> 6, head = (u >> 4) & 3, qb = u & 15; attn_unit<2>(p, l, NCTX + j * 1024 + qb * 64, head, lds); return; }
  u -= 256;
  if (u < 128) { const int b = u >> 2, mt = (u >> 1) & 1, nt = u & 1; fourier_tile(p, b * 256, 256, (size_t)b * 131072, mt, nt, lds); return; }
  u -= 128;
  if (u < 512) { const int b = u >> 4, head = (u >> 1) & 7, qb = u & 1; attn_unit<1>(p, l, b * 256 + qb * 128, head, lds); return; }
  u -= 512;
  { const int b = u >> 4, head = (u >> 2) & 3, qb = u & 3; attn_unit<2>(p, l, b * 256 + qb * 64, head, lds); }
}
constexpr int ATT_UNITS = 256 + 256 + 64 + 512 + 512 + 128;

DEVI void p0a(const Params& p, char* lds) {
  const int t = tid(), nb = gridDim.x, bid = blockIdx.x;
  float* lf = (float*)lds;
  {
    float* sl = lf;
    float* red = lf + 5120;
    bool loaded = false;
    for (int it = bid; it < 384; it += nb) {
      if (!loaded) {
        const float* ca = opq(p.c_ctx); const float* cb = opq(p.c);
        for (int cnd = 0; cnd < 5; ++cnd) {
          const float4 v = *(const float4*)((cnd == 0 ? ca : cb + (cnd - 1) * 1024) + t * 4);
          *(float4*)(sl + cnd * 1024 + t * 4) = make_float4(v.x / (1.f + expf(-v.x)), v.y / (1.f + expf(-v.y)), v.z / (1.f + expf(-v.z)), v.w / (1.f + expf(-v.w)));
        }
        loaded = true;
        __syncthreads();
      }
      const int l = it / 192, cb16 = it % 192, c4 = t & 3, kg = t >> 2;
      const float* wp = p.w_mod + (size_t)l * 1024 * 3072 + cb16 * 16 + c4 * 4 + (size_t)kg * 3072;
      float4 w[16];
#pragma unroll
      for (int i = 0; i < 16; ++i) w[i] = *(const float4*)(wp + (size_t)(64 * i) * 3072);
      float a[5][4];
#pragma unroll
      for (int cnd = 0; cnd < 5; ++cnd)
#pragma unroll
        for (int e = 0; e < 4; ++e) a[cnd][e] = 0.f;
#pragma unroll
      for (int i = 0; i < 16; ++i)
#pragma unroll
        for (int cnd = 0; cnd < 5; ++cnd) { const float sv = sl[cnd * 1024 + kg + 64 * i]; a[cnd][0] += sv * w[i].x; a[cnd][1] += sv * w[i].y; a[cnd][2] += sv * w[i].z; a[cnd][3] += sv * w[i].w; }
#pragma unroll
      for (int cnd = 0; cnd < 5; ++cnd)
#pragma unroll
        for (int e = 0; e < 4; ++e) red[(kg * 5 + cnd) * 16 + c4 * 4 + e] = a[cnd][e];
      __syncthreads();
      if (t < 80) {
        const int cnd = t >> 4, col = t & 15;
        float sum = p.b_mod[l * 3072 + cb16 * 16 + col];
        for (int g = 0; g < 64; ++g) sum += red[(g * 5 + cnd) * 16 + col];
        ((float*)(p.ws + OFF_MOD))[(size_t)(l * 5 + cnd) * 3072 + cb16 * 16 + col] = sum;
      }
      __syncthreads();
    }
    __syncthreads();
  }
  for (int it = bid; it < 1280 + 512 + 384; it += nb) {
    const float* src; bf16_t* dst; int ld, ldd;
    if (it < 1280) {
      const int l = it / 640, r = it % 640, nt = r >> 4, kt = r & 15;
      const int sn0 = nt < 36 ? nt * 64 : 2560 + (nt - 36) * 64, dn0 = nt < 36 ? nt * 64 : 2816 + (nt - 36) * 64;
      src = p.w_in + (size_t)l * 1024 * 2816 + (size_t)(kt * 64) * 2816 + sn0; ld = 2816; ldd = LDP;
      dst = (bf16_t*)(p.ws + OFF_WTIN) + (size_t)l * 3072 * LDP + (size_t)dn0 * LDP + kt * 64;
    } else if (it < 1792) {
      const int q = it - 1280, l = q >> 8, r = q & 255, nt = r >> 4, kt = r & 15;
      src = p.w_out + (size_t)l * 1024 * 1024 + (size_t)(kt * 64) * 1024 + nt * 64; ld = 1024; ldd = LDP;
      dst = (bf16_t*)(p.ws + OFF_WTOUT) + (size_t)l * 1024 * LDP + (size_t)(nt * 64) * LDP + kt * 64;
    } else if (it < 1792 + 128) {
      const int q = it - 1792, j = q >> 5, l = (q >> 4) & 1, pt = (q >> 1) & 7, kvh = q & 1;
      src = p.cache_a + ((size_t)((j * 2 + l) * 512 + pt * 64) * 2 + 1) * 128 + kvh * 64; ld = 256; ldd = 1536;
      dst = (bf16_t*)(p.ws + OFF_VTA) + (size_t)l * KA_L + 1048576 + (size_t)j * 196608 + (size_t)(kvh * 64) * 1536 + 1024 + pt * 64;
    } else {
      const int q = it - 1920, j = q >> 6, l = (q >> 5) & 1, pt = (q >> 2) & 7, hh = q & 3;
      src = p.cache_b + ((size_t)((j * 2 + l) * 512 + pt * 64) * 2 + 1) * 256 + hh * 64; ld = 512; ldd = 1536;
      dst = (bf16_t*)(p.ws + OFF_VTB) + (size_t)l * KB_L + 2097152 + (size_t)j * 393216 + (size_t)(hh * 64) * 1536 + 1024 + pt * 64;
    }
    {
      const int col = t & 63, rw = t >> 6;
#pragma unroll
      for (int i = 0; i < 16; ++i) lf[(rw + 4 * i) * 65 + col] = src[(size_t)(rw + 4 * i) * ld + col];
    }
    __syncthreads();
    {
      const int n = t >> 2, kc = (t & 3) * 16;
      uint32_t w[8];
#pragma unroll
      for (int j = 0; j < 8; ++j) w[j] = pk_bf16(lf[(kc + 2 * j) * 65 + n], lf[(kc + 2 * j + 1) * 65 + n]);
      uint4* d = (uint4*)(dst + (size_t)n * ldd + kc);
      d[0] = make_uint4(w[0], w[1], w[2], w[3]); d[1] = make_uint4(w[4], w[5], w[6], w[7]);
    }
    __syncthreads();
  }
  {
    if (t < 64) { lf[t] = cospif((float)t / 32.f); lf[64 + t] = sinpif((float)t / 32.f); }
    __syncthreads();
    for (int gid = bid * NTHREADS + t; gid < 2 * 256 * 512; gid += nb * NTHREADS) {
      const int l = gid >> 17, r = (gid >> 9) & 255, n = gid & 511, comp = n >> 8, nn = n & 255, g = r >> 6, cc = r & 63;
      const float* wc = p.w_c + (size_t)l * 65536 + (size_t)(g * 64) * 256 + nn;
      const float* tb = lf + comp * 64;
      float s = 0.f;
      float wv[64];
#pragma unroll
      for (int c2 = 0; c2 < 64; ++c2) wv[c2] = wc[(size_t)c2 * 256];
#pragma unroll
      for (int c2 = 0; c2 < 64; ++c2) s += tb[(cc * c2) & 63] * wv[c2];
      ((float*)(p.ws + OFF_W12))[gid] = s;
    }
    __syncthreads();
  }
  for (int gid = bid * NTHREADS + t; gid < 256 * 512; gid += nb * NTHREADS) {
    const int sp = gid >> 9, k = gid & 511, kk = k & 255, m = (sp * kk) & 255;
    const float ang = (float)m / 128.f;
    const float v = (k < 256 ? cospif(ang) : -sinpif(ang)) * (1.f / 128.f);
    ((bf16_t*)(p.ws + OFF_T256))[gid] = f2bf(v);
  }
  for (int gid = bid * NTHREADS + t; gid < 1024 * 2048; gid += nb * NTHREADS) {
    const int sp = gid >> 11, k = gid & 2047, kk = k & 1023, m = (sp * kk) & 1023;
    const float ang = (float)m / 512.f;
    const float v = (k < 1024 ? cospif(ang) : -sinpif(ang)) * (1.f / 256.f);
    ((bf16_t*)(p.ws + OFF_T1024))[gid] = f2bf(v);
  }
  for (int gid = bid * NTHREADS + t; gid < 1024 * 32; gid += nb * NTHREADS) {
    const int s = gid >> 5, j = gid & 31, f = j & 15;
    const float pos = (float)(j < 16 ? (s >> 6) : (s & 63));
    const float inv = 1.0f / powf(10000.f, (float)f / 16.f);
    const float ang = pos * inv;
    float* R = (float*)(p.ws + OFF_ROPEA);
    R[gid] = cosf(ang); R[1024 * 32 + gid] = sinf(ang);
  }
  for (int gid = bid * NTHREADS + t; gid < 1024 * 16; gid += nb * NTHREADS) {
    const int s = gid >> 4, j = gid & 15, f = j & 7;
    const float pos = (float)(j < 8 ? (s >> 6) : (s & 63));
    const float inv = 1.0f / powf(10000.f, (float)f / 8.f);
    const float ang = pos * inv;
    float* R = (float*)(p.ws + OFF_ROPEB);
    R[gid] = cosf(ang); R[1024 * 16 + gid] = sinf(ang);
  }
  float km0 = 0.f, km1 = 0.f, km2 = 0.f, km3 = 0.f;
  {
    const int stride = nb * NTHREADS;
    auto conv_a = [&](int gid, float v) {
      const int cd = gid & 127, pp = (gid >> 7) & 511, l = (gid >> 16) & 1, j = gid >> 17;
      ((bf16_t*)(p.ws + OFF_KA))[(size_t)l * KA_L + (size_t)(NCTX + j * 1536 + 1024 + pp) * 128 + cd] = f2bf(v);
      float ss = v * v;
#pragma unroll
      for (int o = 32; o > 0; o >>= 1) ss += __shfl_xor(ss, o);
      if (l == 0) km0 = fmaxf(km0, ss); else km2 = fmaxf(km2, ss);
    };
    auto src_a = [&](int gid) { return p.cache_a[((size_t)(gid >> 7) * 2) * 128 + (gid & 127)]; };
    int gid = bid * NTHREADS + t;
    for (; gid + 3 * stride < 524288; gid += 4 * stride) {
      const float v0 = src_a(gid), v1 = src_a(gid + stride), v2 = src_a(gid + 2 * stride), v3 = src_a(gid + 3 * stride);
      conv_a(gid, v0); conv_a(gid + stride, v1); conv_a(gid + 2 * stride, v2); conv_a(gid + 3 * stride, v3);
    }
    for (; gid < 524288; gid += stride) conv_a(gid, src_a(gid));
    auto conv_b = [&](int g2, float v) {
      const int cd = g2 & 255, pp = (g2 >> 8) & 511, l = (g2 >> 17) & 1, j = g2 >> 18;
      ((bf16_t*)(p.ws + OFF_KB))[(size_t)l * KB_L + (size_t)(NCTX + j * 1536 + 1024 + pp) * 256 + cd] = f2bf(v);
      float ss = v * v;
#pragma unroll
      for (int o = 16; o > 0; o >>= 1) ss += __shfl_xor(ss, o);
      if (l == 0) km1 = fmaxf(km1, ss); else km3 = fmaxf(km3, ss);
    };
    auto src_b = [&](int g2) { return p.cache_b[((size_t)(g2 >> 8) * 2) * 256 + (g2 & 255)]; };
    gid = bid * NTHREADS + t;
    for (; gid + 3 * stride < 1048576; gid += 4 * stride) {
      const float v0 = src_b(gid), v1 = src_b(gid + stride), v2 = src_b(gid + 2 * stride), v3 = src_b(gid + 3 * stride);
      conv_b(gid, v0); conv_b(gid + stride, v1); conv_b(gid + 2 * stride, v2); conv_b(gid + 3 * stride, v3);
    }
    for (; gid < 1048576; gid += stride) conv_b(gid, src_b(gid));
  }
  {
    km1 = fmaxf(km1, __shfl_xor(km1, 32)); km3 = fmaxf(km3, __shfl_xor(km3, 32));
    __syncthreads();
    if ((t & 63) == 0) { float* sm = lf + (t >> 6) * 4; sm[0] = km0; sm[1] = km1; sm[2] = km2; sm[3] = km3; }
    __syncthreads();
    if (t < 4) ((float*)(p.ws + OFF_KMAXP))[bid * 4 + t] = fmaxf(fmaxf(lf[t], lf[4 + t]), fmaxf(lf[8 + t], lf[12 + t]));
    __syncthreads();
  }
}

DEVI void p0b(const Params& p, char* lds) {
  const int t = tid(), nb = gridDim.x, bid = blockIdx.x;
  float* lf = (float*)lds;
  for (int it = bid; it < 256; it += nb) {
    const int l = it >> 7, kt = (it >> 3) & 15, ntl = it & 7;
    const float* U = p.w_in + (size_t)l * 1024 * 2816 + (size_t)(kt * 64) * 2816 + 2304;
    const float* W = (const float*)(p.ws + OFF_W12) + (size_t)l * 256 * 512 + ntl * 64;
    float* Us = lf;
    float* Ws = lf + 64 * 33;
    const int tk = t >> 4, tn = t & 15;
    float a[4][4];
#pragma unroll
    for (int i = 0; i < 4; ++i)
#pragma unroll
      for (int j = 0; j < 4; ++j) a[i][j] = 0.f;
    for (int rc = 0; rc < 8; ++rc) {
#pragma unroll
      for (int i = 0; i < 8; ++i) { const int e = t + 256 * i, kk = e >> 5, rr = e & 31; Us[kk * 33 + rr] = U[(size_t)kk * 2816 + rc * 32 + rr]; }
#pragma unroll
      for (int i = 0; i < 8; ++i) { const int e = t + 256 * i, rr = e >> 6, nn = e & 63; Ws[rr * 64 + nn] = W[(size_t)(rc * 32 + rr) * 512 + nn]; }
      __syncthreads();
#pragma unroll 8
      for (int r = 0; r < 32; ++r) {
        const float4 w = *(const float4*)(Ws + r * 64 + tn * 4);
#pragma unroll
        for (int i = 0; i < 4; ++i) { const float u = Us[(tk * 4 + i) * 33 + r]; a[i][0] += u * w.x; a[i][1] += u * w.y; a[i][2] += u * w.z; a[i][3] += u * w.w; }
      }
      __syncthreads();
    }
    bf16_t* dst = (bf16_t*)(p.ws + OFF_WTIN) + (size_t)l * 3072 * LDP + (size_t)(2304 + ntl * 64 + tn * 4) * LDP + kt * 64 + tk * 4;
#pragma unroll
    for (int j = 0; j < 4; ++j) st_bf4(dst + (size_t)j * LDP, a[0][j], a[1][j], a[2][j], a[3][j]);
    {
      float* red = lf;
#pragma unroll
      for (int cnd = 0; cnd < 5; ++cnd) {
        const float4 sh = *(const float4*)((const float*)(p.ws + OFF_MOD) + (size_t)(l * 5 + cnd) * 3072 + kt * 64 + tk * 4);
#pragma unroll
        for (int j = 0; j < 4; ++j) red[(tk * 5 + cnd) * 64 + tn * 4 + j] = sh.x * a[0][j] + sh.y * a[1][j] + sh.z * a[2][j] + sh.w * a[3][j];
      }
      __syncthreads();
      for (int o = t; o < 320; o += NTHREADS) {
        const int cnd = o >> 6, n = o & 63;
        float sum = 0.f;
#pragma unroll
        for (int g = 0; g < 16; ++g) sum += red[(g * 5 + cnd) * 64 + n];
        ((float*)(p.ws + OFF_SHWP))[((size_t)(l * 16 + kt) * 5 + cnd) * 512 + ntl * 64 + n] = sum;
      }
      __syncthreads();
    }
  }
  {
    const int lane = t & 63, wave = t >> 6;
    const float* MOD = (const float*)(p.ws + OFF_MOD);
    const int half = nb > 256 ? 256 : 0;
    for (int row = (bid - half) * 4 + wave; bid >= half && row < NTOK; row += (nb - half) * 4) {
      const float* xa = opq(p.x_prompt); const float* xb = opq(p.x_sample);
      const float* x = row < NCTX ? xa + (size_t)row * 1024 : xb + (size_t)(row - NCTX) * 1024;
      const int cond = row < NCTX ? 0 : 1 + ((row - NCTX) >> 10);
      const float* sc = MOD + (size_t)cond * 3072 + 1024;
      bf16_t* hp = (bf16_t*)(p.ws + OFF_HP) + (size_t)row * LDP;
      float ss = 0.f;
      float4 xv[4], gv[4], sv[4];
#pragma unroll
      for (int i = 0; i < 4; ++i) { const int k = i * 256 + lane * 4; xv[i] = *(const float4*)(x + k); gv[i] = *(const float4*)(p.norm_g + k); sv[i] = *(const float4*)(sc + k); }
#pragma unroll
      for (int i = 0; i < 4; ++i) {
        const int k = i * 256 + lane * 4;
        ss += xv[i].x * xv[i].x + xv[i].y * xv[i].y + xv[i].z * xv[i].z + xv[i].w * xv[i].w;
        st_bf4(hp + k, xv[i].x * gv[i].x * (1.f + sv[i].x), xv[i].y * gv[i].y * (1.f + sv[i].y), xv[i].z * gv[i].z * (1.f + sv[i].z), xv[i].w * gv[i].w * (1.f + sv[i].w));
      }
#pragma unroll
      for (int o = 32; o > 0; o >>= 1) ss += __shfl_xor(ss, o);
      if (lane < 16) ((float*)(p.ws + OFF_SSQ))[(size_t)row * 16 + lane] = lane == 0 ? ss : 0.f;
    }
  }
  {
  const int lane = t & 63, wave = t >> 6;
  if (blockIdx.x == 0 && wave == 0) {
    const float4* pp = (const float4*)(p.ws + OFF_KMAXP);
    float4 m = make_float4(0.f, 0.f, 0.f, 0.f);
    for (int i = lane; i < (int)gridDim.x; i += 64) { const float4 v = pp[i]; m.x = fmaxf(m.x, v.x); m.y = fmaxf(m.y, v.y); m.z = fmaxf(m.z, v.z); m.w = fmaxf(m.w, v.w); }
#pragma unroll
    for (int o = 32; o > 0; o >>= 1) { m.x = fmaxf(m.x, __shfl_xor(m.x, o)); m.y = fmaxf(m.y, __shfl_xor(m.y, o)); m.z = fmaxf(m.z, __shfl_xor(m.z, o)); m.w = fmaxf(m.w, __shfl_xor(m.w, o)); }
    if (lane == 0) *(float4*)(p.ws + OFF_KMAX) = m;
  }
  const float* MOD = (const float*)(p.ws + OFF_MOD);
  for (int idx = blockIdx.x * 4 + wave; idx < 2 * 2560; idx += gridDim.x * 4) {
    const int l = idx / 2560, n2 = idx % 2560, n = n2 < 2304 ? n2 : n2 + 512;
    const bf16_t* w = (const bf16_t*)(p.ws + OFF_WTIN) + (size_t)l * 3072 * LDP + (size_t)n * LDP + lane * 16;
    const uint4 w0 = *(const uint4*)w, w1 = *(const uint4*)(w + 8);
    float wf[16];
    wf[0] = __uint_as_float(w0.x << 16); wf[1] = __uint_as_float(w0.x & 0xffff0000u); wf[2] = __uint_as_float(w0.y << 16); wf[3] = __uint_as_float(w0.y & 0xffff0000u);
    wf[4] = __uint_as_float(w0.z << 16); wf[5] = __uint_as_float(w0.z & 0xffff0000u); wf[6] = __uint_as_float(w0.w << 16); wf[7] = __uint_as_float(w0.w & 0xffff0000u);
    wf[8] = __uint_as_float(w1.x << 16); wf[9] = __uint_as_float(w1.x & 0xffff0000u); wf[10] = __uint_as_float(w1.y << 16); wf[11] = __uint_as_float(w1.y & 0xffff0000u);
    wf[12] = __uint_as_float(w1.z << 16); wf[13] = __uint_as_float(w1.z & 0xffff0000u); wf[14] = __uint_as_float(w1.w << 16); wf[15] = __uint_as_float(w1.w & 0xffff0000u);
#pragma unroll
    for (int cnd = 0; cnd < 5; ++cnd) {
      const float* sh = MOD + (size_t)(l * 5 + cnd) * 3072 + lane * 16;
      float s = 0.f;
#pragma unroll
      for (int i = 0; i < 4; ++i) { const float4 s4 = *(const float4*)(sh + i * 4); s += s4.x * wf[i * 4] + s4.y * wf[i * 4 + 1] + s4.z * wf[i * 4 + 2] + s4.w * wf[i * 4 + 3]; }
#pragma unroll
      for (int o = 32; o > 0; o >>= 1) s += __shfl_xor(s, o);
      if (lane == 0) ((float*)(p.ws + OFF_SHW))[(size_t)(l * 5 + cnd) * 3072 + n] = s;
    }
  }
  }
}

constexpr int NPHASES = 8;
DEVI void run_phase(const Params& p, int ph, char* lds) {
  if (ph == 0) { p0a(p, lds); return; }
  if (ph == 1) { p0b(p, lds); return; }
  const int l = (ph - 2) / 3, k = (ph - 2) % 3;
  if (k == 0) {
    for (int it = blockIdx.x; it < 96 * 24; it += gridDim.x) { const int nt = it / 96, mt = it % 96; g1_tile(p, l, mt, nt, lds); }
  } else if (k == 1) {
#if COOP
    unsigned* ctr = (unsigned*)(p.ws + OFF_BAR + 14336) + l * 64;
    volatile LAS unsigned* sh = (volatile LAS unsigned*)(lds + LDS_BYTES) + 2;
    for (;;) {
      if (threadIdx.x == 0) sh[0] = __hip_atomic_fetch_add(ctr, 1u, __ATOMIC_RELAXED, __HIP_MEMORY_SCOPE_AGENT);
      __syncthreads();
      const int u = (int)sh[0];
      __syncthreads();
      if (u >= ATT_UNITS) break;
      att_phase_unit(p, l, u, lds);
    }
#else
    for (int u = blockIdx.x; u < ATT_UNITS; u += gridDim.x) att_phase_unit(p, l, u, lds);
#endif
  } else {
    for (int it = blockIdx.x; it < 768; it += gridDim.x) {
      const int x = it & 7, j = it >> 3, nt = j & 7, mt = (j >> 3) * 8 + x;
      g2_tile(p, l, mt, nt, lds);
    }
  }
}

__global__ void __launch_bounds__(NTHREADS, 2) __attribute__((amdgpu_waves_per_eu(2, 2))) fwd_mega(Params p) {
  extern __shared__ __attribute__((aligned(16))) char lds[];
  cg::grid_group grid = cg::this_grid();
  if (p.ws == nullptr) grid.sync();
  volatile LAS unsigned* st = (volatile LAS unsigned*)(lds + LDS_BYTES);
  if (threadIdx.x == 0) { st[0] = 0u; st[1] = 0u; }
  __syncthreads();
  XcdBarrier xb = xcd_barrier_post((unsigned*)(p.ws + OFF_BAR), st);
  for (int ph = 0; ph < NPHASES; ++ph) {
#if DUPMASK
    if ((DUPMASK >> ph) & 1) { run_phase(p, ph, lds); xcd_barrier(xb); }
#endif
    run_phase(p, ph, lds);
    if (ph + 1 < NPHASES) xcd_barrier(xb);
  }
}

__global__ void __launch_bounds__(NTHREADS, 2) __attribute__((amdgpu_waves_per_eu(2, 2))) fwd_phase(Params p, int ph) {
  extern __shared__ __attribute__((aligned(16))) char lds[];
  run_phase(p, ph, lds);
}

extern "C" void kernel_launch(void* const* d_in, const int* in_sizes, int n_in, void* d_out, int out_size, void* d_ws, size_t ws_size, hipStream_t stream) {
  static int grid_blocks = 0;
  if (!grid_blocks) {
    int dev = 0, cus = 0, per_cu = 0;
    hipGetDevice(&dev);
    hipDeviceGetAttribute(&cus, hipDeviceAttributeMultiprocessorCount, dev);
#if COOP
    hipFuncSetAttribute((const void*)fwd_mega, hipFuncAttributeMaxDynamicSharedMemorySize, LDS_TOTAL);
    hipOccupancyMaxActiveBlocksPerMultiprocessor(&per_cu, (const void*)fwd_mega, NTHREADS, LDS_TOTAL);
    fprintf(stderr, "occupancy query: %d blocks per CU, %d CUs\n", per_cu, cus);
    per_cu = 2;
#else
    hipFuncSetAttribute((const void*)fwd_phase, hipFuncAttributeMaxDynamicSharedMemorySize, LDS_BYTES);
    hipOccupancyMaxActiveBlocksPerMultiprocessor(&per_cu, (const void*)fwd_phase, NTHREADS, LDS_BYTES);
#endif
    if (per_cu < 1) per_cu = 1;
    if (per_cu > 2) per_cu = 2;
    grid_blocks = cus * per_cu;
    if (ws_size < WS_END) fprintf(stderr, "workspace too small: %zu < %zu\n", ws_size, (size_t)WS_END);
  }
  Params p{};
  const float** pp = (const float**)&p;
  for (int i = 0; i < 21; ++i) pp[i] = (const float*)d_in[i];
  p.out = (float*)d_out;
  p.ws = (char*)d_ws;
#if COOP
  void* args[] = {&p};
  hipMemsetAsync((char*)d_ws + OFF_BAR, 0, 16384, stream);
  hipError_t e = hipLaunchCooperativeKernel((const void*)fwd_mega, dim3(grid_blocks), dim3(NTHREADS), args, LDS_TOTAL, stream);
  if (e != hipSuccess) fprintf(stderr, "cooperative launch failed: %s (grid %d)\n", hipGetErrorString(e), grid_blocks);
#else
  for (int ph = 0; ph < NPHASES; ++ph) hipLaunchKernelGGL(fwd_phase, dim3(grid_blocks), dim3(NTHREADS), LDS_BYTES, stream, p, ph);
#endif
}
```
